# Optimizing an MI355X kernel written in HIP

```python
import math
import jax, jax.numpy as jnp
from jax import lax
import numpy as np

D_MODEL = 2048
BATCH = 4
SEQ = 2048
DEPTH = 4

CHUNK = 64
N_MIXERS = 2
EPS = 1e-6

GLA_HEADS = 4
GLA_KEY_WIDTH = D_MODEL // 2
GLA_VAL_WIDTH = D_MODEL
GLA_DK = GLA_KEY_WIDTH // GLA_HEADS
GLA_DV = GLA_VAL_WIDTH // GLA_HEADS
GLA_GATE_RANK = 16
GLA_GATE_TEMP = 16.0
GLA_IN_WIDTH = 2 * GLA_KEY_WIDTH + 2 * GLA_VAL_WIDTH + GLA_GATE_RANK

S5_WIDTH = D_MODEL // 2
S5_GROUP = 16
S5_GROUPS = S5_WIDTH // S5_GROUP
S5_STATE = 64
S5_DT_MIN = 1e-3
S5_DT_MAX = 1e-1
S5_EIG_CLIP = -1e-4

MLP_HIDDEN = 4 * D_MODEL

kernel_name = "hybrid_gla_s5_stream_block"


def _rmsnorm(x, g):
    xf = x.astype(jnp.float32)
    y = xf * lax.rsqrt(jnp.mean(xf * xf, axis=-1, keepdims=True) + EPS)
    return (y * g.astype(jnp.float32)).astype(x.dtype)


def _gla_mixer(h, w_in, w_gate_up, b_gate, o_norm, w_out):
    bsz, seq, _ = h.shape
    nc = seq // CHUNK
    proj = h @ w_in
    q, k, v, r, g_low = jnp.split(
        proj,
        [GLA_KEY_WIDTH, 2 * GLA_KEY_WIDTH, 2 * GLA_KEY_WIDTH + GLA_VAL_WIDTH,
         2 * GLA_KEY_WIDTH + 2 * GLA_VAL_WIDTH], axis=-1)
    log_a = jax.nn.log_sigmoid((g_low @ w_gate_up + b_gate).astype(jnp.float32)) / GLA_GATE_TEMP

    def to_chunks(t, dh):
        return t.reshape(bsz, nc, CHUNK, GLA_HEADS, dh).transpose(1, 0, 3, 2, 4).astype(jnp.float32)

    qc = to_chunks(q, GLA_DK) * (GLA_DK ** -0.5)
    kc = to_chunks(k, GLA_DK)
    vc = to_chunks(v, GLA_DV)
    ac = to_chunks(log_a, GLA_DK)
    cum = jnp.cumsum(ac, axis=3)
    total = cum[:, :, :, -1:, :]
    k_dec = kc * jnp.exp(total - cum)
    chunk_decay = jnp.exp(total[:, :, :, 0, :])

    def step(state, xs):
        q_c, k_c, v_c, d_c = xs
        state = d_c[..., None] * state + jnp.einsum('bhck,bhcv->bhkv', k_c, v_c)
        return state, jnp.einsum('bhck,bhkv->bhcv', q_c, state)

    s0 = jnp.zeros((bsz, GLA_HEADS, GLA_DK, GLA_DV), jnp.float32)
    _, o = lax.scan(step, s0, (qc, k_dec, vc, chunk_decay))
    o = o * lax.rsqrt(jnp.mean(o * o, axis=-1, keepdims=True) + EPS) * o_norm.astype(jnp.float32)
    o = o.transpose(1, 0, 3, 2, 4).reshape(bsz, seq, GLA_VAL_WIDTH).astype(h.dtype)
    return (o * jax.nn.silu(r)) @ w_out


def _s5_mixer(h, w_in, lam_re, lam_im, log_dt, b_re, b_im, c_re, c_im, d_skip, w_out):
    bsz, seq, _ = h.shape
    u = (h @ w_in).astype(jnp.float32)
    ug = u.reshape(bsz, seq, S5_GROUPS, S5_GROUP)
    lr = jnp.minimum(lam_re.astype(jnp.float32), S5_EIG_CLIP)
    li = lam_im.astype(jnp.float32)
    dt = jnp.exp(log_dt.astype(jnp.float32))[:, None]
    mag = jnp.exp(lr * dt)
    ang = li * dt
    ab_re = mag * jnp.cos(ang)
    ab_im = mag * jnp.sin(ang)
    den = lr * lr + li * li
    nr = ab_re - 1.0
    f_re = (nr * lr + ab_im * li) / den
    f_im = (ab_im * lr - nr * li) / den
    br = b_re.astype(jnp.float32)
    bi = b_im.astype(jnp.float32)
    bb_re = f_re[..., None] * br - f_im[..., None] * bi
    bb_im = f_re[..., None] * bi + f_im[..., None] * br
    bu_re = jnp.einsum('gnc,blgc->blgn', bb_re, ug)
    bu_im = jnp.einsum('gnc,blgc->blgn', bb_im, ug)
    a_re = jnp.broadcast_to(ab_re, bu_re.shape)
    a_im = jnp.broadcast_to(ab_im, bu_im.shape)

    def combine(e1, e2):
        a1r, a1i, b1r, b1i = e1
        a2r, a2i, b2r, b2i = e2
        return (a2r * a1r - a2i * a1i,
                a2r * a1i + a2i * a1r,
                a2r * b1r - a2i * b1i + b2r,
                a2r * b1i + a2i * b1r + b2i)

    _, _, x_re, x_im = lax.associative_scan(combine, (a_re, a_im, bu_re, bu_im), axis=1)
    y = (jnp.einsum('gcn,blgn->blgc', c_re.astype(jnp.float32), x_re)
         - jnp.einsum('gcn,blgn->blgc', c_im.astype(jnp.float32), x_im))
    y = y.reshape(bsz, seq, S5_WIDTH) + d_skip.astype(jnp.float32) * u
    y = jax.nn.gelu(y).astype(h.dtype)
    val, gate = jnp.split(y @ w_out, 2, axis=-1)
    return val * jax.nn.sigmoid(gate)


def _sq_relu_mlp(h, w_up, w_down):
    a = jax.nn.relu(h @ w_up)
    return (a * a) @ w_down


def setup_inputs(seed: int = 0) -> dict:
    key = jax.random.key(seed)
    ks = jax.random.split(key, 24)
    n_gla = len(range(0, DEPTH, N_MIXERS))
    n_s5 = len(range(1, DEPTH, N_MIXERS))
    res_scale = (2 * DEPTH) ** -0.5

    def nrm(k, shape, scale):
        return jax.random.normal(k, shape, jnp.float32) * scale

    def gain(k, shape):
        return 1.0 + 0.02 * jax.random.normal(k, shape, jnp.float32)

    lam_im0 = math.pi * jnp.arange(S5_STATE, dtype=jnp.float32)
    return {
        'x': jax.random.normal(ks[0], (BATCH, SEQ, D_MODEL), jnp.float32),
        'gla_norm': gain(ks[1], (n_gla, D_MODEL)),
        'gla_w_in': nrm(ks[2], (n_gla, D_MODEL, GLA_IN_WIDTH), D_MODEL ** -0.5),
        'gla_w_gate_up': nrm(ks[3], (n_gla, GLA_GATE_RANK, GLA_KEY_WIDTH), GLA_GATE_RANK ** -0.5),
        'gla_b_gate': 1.0 + 0.1 * jax.random.normal(ks[4], (n_gla, GLA_KEY_WIDTH), jnp.float32),
        'gla_o_norm': gain(ks[5], (n_gla, GLA_DV)),
        'gla_w_out': nrm(ks[6], (n_gla, GLA_VAL_WIDTH, D_MODEL), GLA_VAL_WIDTH ** -0.5 * res_scale),
        's5_norm': gain(ks[7], (n_s5, D_MODEL)),
        's5_w_in': nrm(ks[8], (n_s5, D_MODEL, S5_WIDTH), D_MODEL ** -0.5),
        's5_lam_re': -0.5 + 0.01 * jax.random.normal(ks[9], (n_s5, S5_GROUPS, S5_STATE), jnp.float32),
        's5_lam_im': lam_im0 + 0.01 * jax.random.normal(ks[10], (n_s5, S5_GROUPS, S5_STATE), jnp.float32),
        's5_log_dt': jax.random.uniform(ks[11], (n_s5, S5_GROUPS), jnp.float32,
                                        minval=math.log(S5_DT_MIN), maxval=math.log(S5_DT_MAX)),
        's5_b_re': nrm(ks[12], (n_s5, S5_GROUPS, S5_STATE, S5_GROUP), (2 * S5_GROUP) ** -0.5),
        's5_b_im': nrm(ks[13], (n_s5, S5_GROUPS, S5_STATE, S5_GROUP), (2 * S5_GROUP) ** -0.5),
        's5_c_re': nrm(ks[14], (n_s5, S5_GROUPS, S5_GROUP, S5_STATE), (2 * S5_STATE) ** -0.5),
        's5_c_im': nrm(ks[15], (n_s5, S5_GROUPS, S5_GROUP, S5_STATE), (2 * S5_STATE) ** -0.5),
        's5_d': jax.random.normal(ks[16], (n_s5, S5_WIDTH), jnp.float32),
        's5_w_out': nrm(ks[17], (n_s5, S5_WIDTH, 2 * D_MODEL), S5_WIDTH ** -0.5 * res_scale),
        'mlp_norm': gain(ks[18], (DEPTH, D_MODEL)),
        'mlp_w_up': nrm(ks[19], (DEPTH, D_MODEL, MLP_HIDDEN), D_MODEL ** -0.5),
        'mlp_w_down': nrm(ks[20], (DEPTH, MLP_HIDDEN, D_MODEL), MLP_HIDDEN ** -0.5 * res_scale),
        'final_norm': gain(ks[21], (D_MODEL,)),
    }


def reference(x, gla_norm, gla_w_in, gla_w_gate_up, gla_b_gate, gla_o_norm, gla_w_out,
              s5_norm, s5_w_in, s5_lam_re, s5_lam_im, s5_log_dt, s5_b_re, s5_b_im,
              s5_c_re, s5_c_im, s5_d, s5_w_out, mlp_norm, mlp_w_up, mlp_w_down, final_norm):
    h = x
    for i in range(DEPTH):
        j = i // N_MIXERS
        if i % N_MIXERS == 0:
            h = h + _gla_mixer(_rmsnorm(h, gla_norm[j]), gla_w_in[j], gla_w_gate_up[j],
                               gla_b_gate[j], gla_o_norm[j], gla_w_out[j])
        else:
            h = h + _s5_mixer(_rmsnorm(h, s5_norm[j]), s5_w_in[j], s5_lam_re[j], s5_lam_im[j],
                              s5_log_dt[j], s5_b_re[j], s5_b_im[j], s5_c_re[j], s5_c_im[j],
                              s5_d[j], s5_w_out[j])
        h = h + _sq_relu_mlp(_rmsnorm(h, mlp_norm[i]), mlp_w_up[i], mlp_w_down[i])
    return _rmsnorm(h, final_norm)
```

```cpp
#include <hip/hip_runtime.h>
#include <hip/hip_cooperative_groups.h>
#include <cstdio>
#include <cstdint>
namespace cg = cooperative_groups;

#ifndef MK_MULTI
#define MK_MULTI 0
#endif
#ifndef PROBE_MASK
#define PROBE_MASK 0
#endif

#define LAS __attribute__((address_space(3)))
typedef unsigned short bf16_t;
typedef short bf16x8 __attribute__((ext_vector_type(8)));
typedef float f32x4 __attribute__((ext_vector_type(4)));
typedef float f32x2 __attribute__((ext_vector_type(2)));
typedef unsigned u32x4 __attribute__((ext_vector_type(4)));
typedef unsigned u32x2 __attribute__((ext_vector_type(2)));

constexpr int D = 2048, BATCH = 4, SEQ = 2048, M = BATCH * SEQ, DEPTH = 4;
constexpr int GIN = 6160, GIN_PAD = 6400, GPROJ = 6144;
constexpr int KW = 1024, VW = 2048, DK = 256, DV = 512, NH = 4, CH = 64, NCH = SEQ / CH;
constexpr int S5W = 1024, S5G = 64, S5N = 64;
constexpr int FF = 8192;
constexpr float EPS = 1e-6f;

constexpr size_t MiB = 1u << 20;
constexpr size_t WS_WGIN = 0;
constexpr size_t WS_WGOUT = WS_WGIN + 50 * MiB;
constexpr size_t WS_WSIN = WS_WGOUT + 16 * MiB;
constexpr size_t WS_WSOUT = WS_WSIN + 8 * MiB;
constexpr size_t WS_WUP = WS_WSOUT + 16 * MiB;
constexpr size_t WS_WDN = WS_WUP + 128 * MiB;
constexpr size_t WS_HN = WS_WDN + 128 * MiB;
constexpr size_t WS_Y = WS_HN + 32 * MiB;
constexpr size_t WS_PROJ = WS_Y + 32 * MiB;
constexpr size_t WS_GLOW = WS_PROJ + 96 * MiB;
constexpr size_t WS_KDT = WS_GLOW + 1 * MiB;
constexpr size_t WS_DCH = WS_KDT + 16 * MiB;
constexpr size_t WS_O = WS_DCH + 1 * MiB;
constexpr size_t WS_A = WS_O + 32 * MiB;
constexpr size_t WS_UG = WS_A + 128 * MiB;
constexpr size_t WS_YS = WS_UG + 32 * MiB;
constexpr size_t WS_SS = WS_YS + 16 * MiB;
constexpr size_t WS_CTL = WS_SS + 2 * MiB;
constexpr size_t CTL_BYTES = 65536;
constexpr size_t WS_END = WS_CTL + 1 * MiB;

constexpr int NWAVES = 8, NTHREADS = 512;
constexpr int LDS_BYTES = 147456;
constexpr int LDS_RSTD = 131072;
constexpr int LDS_MISC = LDS_BYTES - 64;

namespace pg8 {
constexpr int BM = 256, BK = 64, HALF = 128, HTB = HALF * BK * 2, STAGE_BYTES = 8 * HTB, NXCD = 8, WGM = 4;
__device__ __forceinline__ int lds_byte(int r, int c) { const int st = (r >> 4) * 2 + (c >> 5), rr = r & 15, cc = c & 31, ob = rr * 64 + cc * 2; return st * 1024 + (ob ^ (((ob >> 9) & 1) << 5)); }
__device__ __forceinline__ void stage_rc(int b, int& R, int& C) { const int st = b / 1024, sb = b % 1024, swz = sb ^ (((sb >> 9) & 1) << 5); R = (st >> 1) * 16 + swz / 64; C = (st & 1) * 32 + (swz % 64) / 2; }
__device__ __forceinline__ int perm32(int rho) { const int n = rho >> 4, i = rho & 15; return 8 * (i >> 2) + 4 * n + (i & 3); }

struct Unit { int pm, pn; };
struct Gemm { const bf16_t* A; const bf16_t* Bt; };

template <int N_> struct StaticOrder {
    static constexpr int nM = ::M / BM, nN = N_ / BM, nwg = nM * nN;
    int G, c;
    __device__ __forceinline__ void init(int G_, int c_) { G = G_; c = c_; }
    __device__ __forceinline__ bool next(int i, Unit& u) const {
        const int L = i * G + c; if (L >= nwg) return false;
        int wgid = L; { constexpr int q = nwg / NXCD, r = nwg % NXCD; const int xcd = wgid % NXCD, off = wgid / NXCD; wgid = (xcd < r ? xcd * (q + 1) : r * (q + 1) + (xcd - r) * q) + off; }
        constexpr int nig = WGM * nN; const int gid = wgid / nig, fm = gid * WGM, gsz = (nM - fm) < WGM ? (nM - fm) : WGM;
        u.pm = fm + ((wgid % nig) % gsz); u.pn = (wgid % nig) / gsz; return true;
    }
};

typedef __bf16 nbf16x2 __attribute__((ext_vector_type(2)));
__device__ __forceinline__ unsigned cvt_pk_bf16(float lo, float hi) { const f32x2 v = {lo, hi}; const nbf16x2 b = __builtin_convertvector(v, nbf16x2); return __builtin_bit_cast(unsigned, b); }

struct EpiProj {
    static constexpr bool PERM = true;
    bf16_t* P; const LAS float* rs;
    __device__ __forceinline__ void operator()(const f32x4 (&acc)[2][2][4][2], const Unit& u, int ui, int wr, int wc, int fr, int fq) const {
        const int row0 = u.pm * BM + wr * 64 + fr, col0 = u.pn * BM + wc * 32 + 8 * fq;
#pragma unroll
        for (int ai = 0; ai < 2; ++ai)
#pragma unroll
            for (int m = 0; m < 4; ++m) { bf16_t* rowp = P + (size_t)(row0 + ai * HALF + m * 16) * GPROJ + col0; const float sc = rs[ui * 256 + wr * 64 + fr + ai * HALF + m * 16];
#pragma unroll
                for (int bj = 0; bj < 2; ++bj) { const f32x4 v0 = acc[ai][bj][m][0] * sc, v1 = acc[ai][bj][m][1] * sc;
                    u32x4 w; w.x = cvt_pk_bf16(v0[0], v0[1]); w.y = cvt_pk_bf16(v0[2], v0[3]); w.z = cvt_pk_bf16(v1[0], v1[1]); w.w = cvt_pk_bf16(v1[2], v1[3]);
                    *(u32x4*)(rowp + bj * HALF) = w; } }
    }
};
struct EpiRelu2 {
    static constexpr bool PERM = true;
    bf16_t* O; const LAS float* rs;
    __device__ __forceinline__ void operator()(const f32x4 (&acc)[2][2][4][2], const Unit& u, int ui, int wr, int wc, int fr, int fq) const {
        const int row0 = u.pm * BM + wr * 64 + fr, col0 = u.pn * BM + wc * 32 + 8 * fq;
#pragma unroll
        for (int ai = 0; ai < 2; ++ai)
#pragma unroll
            for (int m = 0; m < 4; ++m) { bf16_t* rowp = O + (size_t)(row0 + ai * HALF + m * 16) * FF + col0; const float sc = rs[ui * 256 + wr * 64 + fr + ai * HALF + m * 16];
#pragma unroll
                for (int bj = 0; bj < 2; ++bj) { f32x4 v0 = acc[ai][bj][m][0] * sc, v1 = acc[ai][bj][m][1] * sc;
#pragma unroll
                    for (int j = 0; j < 4; ++j) { const float a = fmaxf(v0[j], 0.f), b = fmaxf(v1[j], 0.f); v0[j] = a * a; v1[j] = b * b; }
                    u32x4 w; w.x = cvt_pk_bf16(v0[0], v0[1]); w.y = cvt_pk_bf16(v0[2], v0[3]); w.z = cvt_pk_bf16(v1[0], v1[1]); w.w = cvt_pk_bf16(v1[2], v1[3]);
                    *(u32x4*)(rowp + bj * HALF) = w; } }
    }
};
struct EpiResid {
    static constexpr bool PERM = false;
    const float* base; float* out; bf16_t* hb; float* ss;
    __device__ __forceinline__ void operator()(const f32x4 (&acc)[2][2][4][2], const Unit& u, int ui, int wr, int wc, int fr, int fq) const {
        const int row0 = u.pm * BM + wr * 64 + fr, col0 = u.pn * BM + wc * 32 + 4 * fq;
#pragma unroll
        for (int ai = 0; ai < 2; ++ai)
#pragma unroll
            for (int m = 0; m < 4; ++m) { const int row = row0 + ai * HALF + m * 16; const size_t ro = (size_t)row * D + col0; float sq = 0.f;
#pragma unroll
                for (int bj = 0; bj < 2; ++bj)
#pragma unroll
                    for (int n = 0; n < 2; ++n) { const size_t o = ro + bj * HALF + n * 16; const f32x4 r = *(const f32x4*)(base + o) + acc[ai][bj][m][n]; *(f32x4*)(out + o) = r;
                        sq += (r[0] * r[0] + r[1] * r[1]) + (r[2] * r[2] + r[3] * r[3]);
                        u32x2 w; w.x = cvt_pk_bf16(r[0], r[1]); w.y = cvt_pk_bf16(r[2], r[3]); *(u32x2*)(hb + o) = w; }
                sq += __shfl_xor(sq, 16); sq += __shfl_xor(sq, 32);
                if (fq == 0) ss[(size_t)row * 64 + u.pn * 4 + wc] = sq; }
    }
};
struct EpiU {
    static constexpr bool PERM = false;
    float* ug; const LAS float* rs;
    __device__ __forceinline__ void operator()(const f32x4 (&acc)[2][2][4][2], const Unit& u, int ui, int wr, int wc, int fr, int fq) const {
        const int row0 = u.pm * BM + wr * 64 + fr;
#pragma unroll
        for (int ai = 0; ai < 2; ++ai)
#pragma unroll
            for (int m = 0; m < 4; ++m) { const int row = row0 + ai * HALF + m * 16, b = row / SEQ, t = row % SEQ; const float sc = rs[ui * 256 + wr * 64 + fr + ai * HALF + m * 16];
#pragma unroll
                for (int bj = 0; bj < 2; ++bj)
#pragma unroll
                    for (int n = 0; n < 2; ++n) { const int grp = 16 * u.pn + 8 * bj + 2 * wc + n;
                        *(f32x4*)(ug + ((size_t)(b * S5G + grp) * SEQ + t) * 16 + 4 * fq) = acc[ai][bj][m][n] * sc; } }
    }
};
struct EpiGlu {
    static constexpr bool PERM = false;
    const float* base; float* out; bf16_t* hb; float* ss;
    __device__ __forceinline__ void operator()(const f32x4 (&acc)[2][2][4][2], const Unit& u, int ui, int wr, int wc, int fr, int fq) const {
        const int row0 = u.pm * BM + wr * 64 + fr, col0 = u.pn * HALF + wc * 32 + 4 * fq;
#pragma unroll
        for (int ai = 0; ai < 2; ++ai)
#pragma unroll
            for (int m = 0; m < 4; ++m) { const int row = row0 + ai * HALF + m * 16; const size_t ro = (size_t)row * D + col0; float sq = 0.f;
#pragma unroll
                for (int n = 0; n < 2; ++n) { const size_t o = ro + n * 16; const f32x4 v = acc[ai][0][m][n], gt = acc[ai][1][m][n]; f32x4 r = *(const f32x4*)(base + o);
#pragma unroll
                    for (int j = 0; j < 4; ++j) r[j] += v[j] / (1.f + __expf(-gt[j]));
                    *(f32x4*)(out + o) = r;
                    sq += (r[0] * r[0] + r[1] * r[1]) + (r[2] * r[2] + r[3] * r[3]);
                    u32x2 w; w.x = cvt_pk_bf16(r[0], r[1]); w.y = cvt_pk_bf16(r[2], r[3]); *(u32x2*)(hb + o) = w; }
                sq += __shfl_xor(sq, 16); sq += __shfl_xor(sq, 32);
                if (fq == 0) ss[(size_t)row * 64 + u.pn * 4 + wc] = sq; }
    }
};

template <int N> __device__ __forceinline__ void rstd_prestep(LAS unsigned char* lds, const int tid, const int G_, const int c_, const float* __restrict__ ss, const int nss) {
    StaticOrder<N> S; S.init(G_, c_);
    LAS float* rs = (LAS float*)(lds + LDS_RSTD);
    const int r = tid >> 1, hf = tid & 1, cnt = nss >> 1;
    Unit u;
    for (int i = 0; i < 8; ++i) {
        if (!S.next(i, u)) break;
        const float* p = ss + (size_t)(u.pm * BM + r) * 64 + hf * cnt;
        float sm = 0.f;
        for (int k = 0; k < cnt; k += 4) { const f32x4 v = *(const f32x4*)(p + k); sm += (v.x + v.y) + (v.z + v.w); }
        sm += __shfl_xor(sm, 1);
        if (hf == 0) rs[i * 256 + r] = 1.f / sqrtf(sm * (1.f / D) + EPS);
    }
    __syncthreads();
}

template <class Epi, int N, int K, bool KREV = false, bool ALIGN_EPI = true, bool SP2 = true>
__device__ __forceinline__ void gemm_phase(LAS unsigned char* lds, const int tid, const Gemm g, const int G_, const int c_, const Epi& E) {
    StaticOrder<N> S; S.init(G_, c_);
    const int wid = __builtin_amdgcn_readfirstlane(tid >> 6), lane = tid & 63, wr = wid >> 2, wc = wid & 3, fr = lane & 15, fq = lane >> 4;
    constexpr int nt = K / BK;
    unsigned voffA[2], voffB[2];
#pragma unroll
    for (int i = 0; i < 2; ++i) { int R, C; stage_rc(tid * 16 + i * 8192, R, C); const int Rb = Epi::PERM ? ((R & ~31) + perm32(R & 31)) : R;
        voffA[i] = (unsigned)(R * K + C) * 2u; voffB[i] = (unsigned)(Rb * K + C) * 2u; }
    constexpr long kstep = KREV ? -(long)(BK * 2) : (long)(BK * 2);
    constexpr size_t kfirst = KREV ? (size_t)(K - BK) * 2 : (size_t)0;
    constexpr size_t hstep = (size_t)HALF * K * 2;
    constexpr size_t tstep = 2 * hstep;
    const unsigned ldsw = (unsigned)wid * 1024u;
    const int aoff = lds_byte(wr * 64 + fr, fq * 8), boff = lds_byte(wc * 32 + fr, fq * 8);
#define PG8_SA(b, h) (((b) * 2 + (h)) * HTB)
#define PG8_SB(b, h) ((4 + (b) * 2 + (h)) * HTB)
#define PG8_STAGE(bufoff, gbase, voff) do { _Pragma("unroll") for (int _i = 0; _i < 2; ++_i) \
        __builtin_amdgcn_global_load_lds((const unsigned*)((const char*)(gbase) + (voff)[_i]), (LAS unsigned*)(lds + (bufoff) + ldsw + _i * 8192), 16, 0, 0); } while (0)
#define PG8_LDA(dst, b, h) do { _Pragma("unroll") for (int m = 0; m < 4; ++m) _Pragma("unroll") for (int k = 0; k < 2; ++k) dst[m][k] = *(const LAS bf16x8*)(lds + PG8_SA(b, h) + aoff + m * 2048 + k * 1024); } while (0)
#define PG8_LDB(dst, b, h) do { _Pragma("unroll") for (int n = 0; n < 2; ++n) _Pragma("unroll") for (int k = 0; k < 2; ++k) dst[n][k] = *(const LAS bf16x8*)(lds + PG8_SB(b, h) + boff + n * 2048 + k * 1024); } while (0)
#define PG8_MMA(ai, bj, At, Bt) do { __builtin_amdgcn_s_setprio(1); _Pragma("unroll") for (int m = 0; m < 4; ++m) _Pragma("unroll") for (int n = 0; n < 2; ++n) _Pragma("unroll") for (int k = 0; k < 2; ++k) \
        acc[ai][bj][m][n] = __builtin_amdgcn_mfma_f32_16x16x32_bf16(Bt[n][k], At[m][k], acc[ai][bj][m][n], 0, 0, 0); __builtin_amdgcn_s_setprio(0); } while (0)
#define PG8_WAIT_V(n) asm volatile("s_waitcnt vmcnt(" #n ")" ::: "memory")
#define PG8_WAIT_L(n) asm volatile("s_waitcnt lgkmcnt(" #n ")" ::: "memory")
#define PG8_BAR __builtin_amdgcn_s_barrier()
#define PG8_SCHED __builtin_amdgcn_sched_barrier(0)
    Unit cur, nxt; int ui = 0;
    if (!S.next(0, cur)) return;
    f32x4 acc[2][2][4][2];
#pragma unroll
    for (int a = 0; a < 2; ++a)
#pragma unroll
        for (int b = 0; b < 2; ++b)
#pragma unroll
            for (int m = 0; m < 4; ++m)
#pragma unroll
                for (int n = 0; n < 2; ++n) acc[a][b][m][n] = (f32x4){0.f, 0.f, 0.f, 0.f};
    bf16x8 At[4][2], B0[2][2], B1[2][2];
    const char* cA = (const char*)g.A + (size_t)cur.pm * tstep + kfirst; const char* cB = (const char*)g.Bt + (size_t)cur.pn * tstep + kfirst;
    if constexpr (SP2) {
        PG8_STAGE(PG8_SB(0, 0), cB, voffB); PG8_STAGE(PG8_SB(0, 1), cB + hstep, voffB); PG8_STAGE(PG8_SA(0, 0), cA, voffA); PG8_STAGE(PG8_SA(0, 1), cA + hstep, voffA);
        if (wr == 1) PG8_BAR;
        PG8_WAIT_V(2); PG8_BAR;
        PG8_STAGE(PG8_SB(1, 0), cB + kstep, voffB); PG8_STAGE(PG8_SA(1, 0), cA + kstep, voffA); PG8_STAGE(PG8_SB(1, 1), cB + hstep + kstep, voffB);
        PG8_WAIT_V(6); PG8_BAR;
    } else {
        PG8_STAGE(PG8_SB(0, 0), cB, voffB); PG8_STAGE(PG8_SA(0, 0), cA, voffA); PG8_STAGE(PG8_SB(0, 1), cB + hstep, voffB); PG8_STAGE(PG8_SA(0, 1), cA + hstep, voffA);
        if (wr == 1) PG8_BAR;
        PG8_WAIT_V(4); PG8_BAR;
        PG8_STAGE(PG8_SB(1, 0), cB + kstep, voffB); PG8_STAGE(PG8_SA(1, 0), cA + kstep, voffA); PG8_STAGE(PG8_SB(1, 1), cB + hstep + kstep, voffB);
        PG8_WAIT_V(6); PG8_BAR;
    }
    for (;;) {
        const bool has_next = S.next(ui + 1, nxt);
        const char* nA = has_next ? (const char*)g.A + (size_t)nxt.pm * tstep + kfirst : cA; const char* nB = has_next ? (const char*)g.Bt + (size_t)nxt.pn * tstep + kfirst : cB;
        for (int t = 0; t < nt; t += 2) {
            const bool last = (t == nt - 2);
            const char* a1 = cA + (long)(t + 1) * kstep;
            const char* a2 = last ? nA : cA + (long)(t + 2) * kstep; const char* b2 = last ? nB : cB + (long)(t + 2) * kstep;
            const char* a3 = a2 + kstep; const char* b3 = b2 + kstep;
            if constexpr (SP2) {
            PG8_LDB(B0, 0, 0); PG8_LDB(B1, 0, 1); PG8_SCHED; PG8_LDA(At, 0, 0); PG8_STAGE(PG8_SA(1, 1), a1 + hstep, voffA);
            PG8_WAIT_V(8); PG8_WAIT_L(0); PG8_BAR; PG8_MMA(0, 0, At, B0); PG8_MMA(0, 1, At, B1); PG8_BAR; PG8_SCHED;
            PG8_LDA(At, 0, 1); PG8_STAGE(PG8_SB(0, 0), b2, voffB); PG8_STAGE(PG8_SB(0, 1), b2 + hstep, voffB); PG8_STAGE(PG8_SA(0, 0), a2, voffA);
            PG8_WAIT_V(8); PG8_WAIT_L(0); PG8_BAR; PG8_MMA(1, 0, At, B0); PG8_MMA(1, 1, At, B1); PG8_BAR; PG8_SCHED;
            PG8_LDB(B0, 1, 0); PG8_LDB(B1, 1, 1); PG8_SCHED; PG8_LDA(At, 1, 0); PG8_STAGE(PG8_SA(0, 1), a2 + hstep, voffA);
            PG8_WAIT_V(8); PG8_WAIT_L(0); PG8_BAR; PG8_MMA(0, 0, At, B0); PG8_MMA(0, 1, At, B1); PG8_BAR; PG8_SCHED;
            PG8_LDA(At, 1, 1); PG8_STAGE(PG8_SB(1, 0), b3, voffB); PG8_STAGE(PG8_SB(1, 1), b3 + hstep, voffB); PG8_STAGE(PG8_SA(1, 0), a3, voffA);
            PG8_WAIT_V(8); PG8_WAIT_L(0); PG8_BAR; PG8_MMA(1, 0, At, B0); PG8_MMA(1, 1, At, B1); PG8_BAR; PG8_SCHED;
            } else {
            PG8_LDB(B0, 0, 0); PG8_SCHED; PG8_LDA(At, 0, 0); PG8_STAGE(PG8_SA(1, 1), a1 + hstep, voffA);
            PG8_WAIT_L(8); PG8_BAR; PG8_WAIT_L(0); PG8_MMA(0, 0, At, B0); PG8_BAR; PG8_SCHED;
            PG8_LDB(B1, 0, 1); PG8_STAGE(PG8_SB(0, 0), b2, voffB);
            PG8_BAR; PG8_WAIT_L(0); PG8_MMA(0, 1, At, B1); PG8_BAR;
            PG8_LDA(At, 0, 1); PG8_STAGE(PG8_SA(0, 0), a2, voffA);
            PG8_BAR; PG8_WAIT_L(0); PG8_MMA(1, 0, At, B0); PG8_BAR; PG8_SCHED;
            PG8_STAGE(PG8_SB(0, 1), b2 + hstep, voffB);
            PG8_WAIT_V(6); PG8_BAR; PG8_MMA(1, 1, At, B1); PG8_BAR;
            PG8_LDB(B0, 1, 0); PG8_SCHED; PG8_LDA(At, 1, 0); PG8_STAGE(PG8_SA(0, 1), a2 + hstep, voffA);
            PG8_WAIT_L(8); PG8_BAR; PG8_WAIT_L(0); PG8_MMA(0, 0, At, B0); PG8_BAR; PG8_SCHED;
            PG8_LDB(B1, 1, 1); PG8_STAGE(PG8_SB(1, 0), b3, voffB);
            PG8_BAR; PG8_WAIT_L(0); PG8_MMA(0, 1, At, B1); PG8_BAR;
            PG8_LDA(At, 1, 1); PG8_STAGE(PG8_SA(1, 0), a3, voffA);
            PG8_BAR; PG8_WAIT_L(0); PG8_MMA(1, 0, At, B0); PG8_BAR; PG8_SCHED;
            PG8_STAGE(PG8_SB(1, 1), b3 + hstep, voffB);
            PG8_WAIT_V(6); PG8_BAR; PG8_MMA(1, 1, At, B1); PG8_BAR;
            }
        }
        if constexpr (ALIGN_EPI) { if (wr == 0) PG8_BAR; }
        E(acc, cur, ui, wr, wc, fr, fq);
        if (!has_next) break;
#pragma unroll
        for (int a = 0; a < 2; ++a)
#pragma unroll
            for (int b = 0; b < 2; ++b)
#pragma unroll
                for (int m = 0; m < 4; ++m)
#pragma unroll
                    for (int n = 0; n < 2; ++n) acc[a][b][m][n] = (f32x4){0.f, 0.f, 0.f, 0.f};
        cur = nxt; cA = nA; cB = nB; ++ui;
        if constexpr (ALIGN_EPI) { if (wr == 1) PG8_BAR; }
    }
    PG8_WAIT_V(0);
    if constexpr (!ALIGN_EPI) { if (wr == 0) PG8_BAR; }
    PG8_BAR;
#undef PG8_SA
#undef PG8_SB
#undef PG8_STAGE
#undef PG8_LDA
#undef PG8_LDB
#undef PG8_MMA
#undef PG8_WAIT_V
#undef PG8_WAIT_L
#undef PG8_BAR
#undef PG8_SCHED
}
}

#define LDS_WAIT() asm volatile("s_waitcnt lgkmcnt(0)" ::: "memory")
__device__ __forceinline__ unsigned pk2(float lo, float hi) { return pg8::cvt_pk_bf16(lo, hi); }
__device__ __forceinline__ float bf2f(bf16_t b) { return __uint_as_float(((unsigned)b) << 16); }
__device__ __forceinline__ float bflo(unsigned w) { return __uint_as_float(w << 16); }
__device__ __forceinline__ float bfhi(unsigned w) { return __uint_as_float(w & 0xffff0000u); }
__device__ __forceinline__ float wave_sum(float v) {
#pragma unroll
    for (int o = 1; o < 64; o <<= 1) v += __shfl_xor(v, o);
    return v;
}

__device__ __forceinline__ void tr_item(const float* __restrict__ W, int K, int Nsrc, bf16_t* __restrict__ WT, LAS float* scr, int kb, int nb, int lane, bool glu, const float* __restrict__ gain) {
    const int k0 = 64 * kb, n0 = 64 * nb, c4 = lane & 15, rg = lane >> 4, nn = n0 + 4 * c4; const bool ok = nn < Nsrc;
    const float* src = W + (size_t)(k0 + rg) * Nsrc + (ok ? nn : 0);
    f32x4 v[16];
#pragma unroll
    for (int i = 0; i < 16; ++i) v[i] = *(const f32x4*)(src + (size_t)(4 * i) * Nsrc);
#pragma unroll
    for (int i = 0; i < 16; ++i) { LAS float* d = scr + (4 * i + rg) * 65 + 4 * c4; const float gk = gain ? gain[k0 + 4 * i + rg] : 1.f; const f32x4 x = ok ? v[i] * gk : (f32x4){0.f, 0.f, 0.f, 0.f}; d[0] = x.x; d[1] = x.y; d[2] = x.z; d[3] = x.w; }
    LDS_WAIT(); asm volatile("" ::: "memory");
    int dest0 = n0;
    if (glu) dest0 = (n0 < 2048) ? (n0 / 128) * 256 + (n0 % 128) : ((n0 - 2048) / 128) * 256 + 128 + ((n0 - 2048) % 128);
    const int c = lane & 7;
#pragma unroll
    for (int j = 0; j < 8; ++j) { const int n = (lane >> 3) + 8 * j; const LAS float* s = scr + (8 * c) * 65 + n;
        u32x4 o; o.x = pk2(s[0 * 65], s[1 * 65]); o.y = pk2(s[2 * 65], s[3 * 65]); o.z = pk2(s[4 * 65], s[5 * 65]); o.w = pk2(s[6 * 65], s[7 * 65]);
        *(u32x4*)(WT + (size_t)(dest0 + n) * K + k0 + 8 * c) = o; }
    LDS_WAIT(); asm volatile("" ::: "memory");
}

__device__ __forceinline__ void norm_rows_bf16(const float* __restrict__ src, const float* __restrict__ gain, bf16_t* __restrict__ dst, int gw, int NGW, int lane) {
    f32x4 gv[8];
#pragma unroll
    for (int j = 0; j < 8; ++j) gv[j] = *(const f32x4*)(gain + 4 * lane + 256 * j);
    for (int m = gw; m < M; m += NGW) {
        const f32x4* xr = (const f32x4*)(src + (size_t)m * D) + lane;
        f32x4 v[8]; float s = 0.f;
#pragma unroll
        for (int j = 0; j < 8; ++j) { v[j] = xr[64 * j]; s += (v[j].x * v[j].x + v[j].y * v[j].y) + (v[j].z * v[j].z + v[j].w * v[j].w); }
        const float rstd = 1.f / sqrtf(wave_sum(s) * (1.f / D) + EPS);
        u32x2* o8 = (u32x2*)(dst + (size_t)m * D) + lane;
#pragma unroll
        for (int j = 0; j < 8; ++j) { u32x2 w; w.x = pk2(v[j].x * rstd * gv[j].x, v[j].y * rstd * gv[j].y); w.y = pk2(v[j].z * rstd * gv[j].z, v[j].w * rstd * gv[j].w); o8[64 * j] = w; }
    }
}
__device__ __forceinline__ void prep_rows(const float* __restrict__ src, bf16_t* __restrict__ dst, float* __restrict__ ss, int gw, int NGW, int lane) {
    for (int m = gw; m < M; m += NGW) {
        const f32x4* xr = (const f32x4*)(src + (size_t)m * D) + lane;
        f32x4 v[8]; float s = 0.f;
#pragma unroll
        for (int j = 0; j < 8; ++j) { v[j] = xr[64 * j]; s += (v[j].x * v[j].x + v[j].y * v[j].y) + (v[j].z * v[j].z + v[j].w * v[j].w); }
        s = wave_sum(s);
        u32x2* o8 = (u32x2*)(dst + (size_t)m * D) + lane;
#pragma unroll
        for (int j = 0; j < 8; ++j) { u32x2 w; w.x = pk2(v[j].x, v[j].y); w.y = pk2(v[j].z, v[j].w); o8[64 * j] = w; }
        if (lane < 32) ss[(size_t)m * 64 + lane] = lane == 0 ? s : 0.f;
    }
}
__device__ __forceinline__ void norm_rows_f32(float* __restrict__ io, const float* __restrict__ gain, int gw, int NGW, int lane) {
    f32x4 gv[8];
#pragma unroll
    for (int j = 0; j < 8; ++j) gv[j] = *(const f32x4*)(gain + 4 * lane + 256 * j);
    for (int m = gw; m < M; m += NGW) {
        f32x4* xr = (f32x4*)(io + (size_t)m * D) + lane;
        f32x4 v[8]; float s = 0.f;
#pragma unroll
        for (int j = 0; j < 8; ++j) { v[j] = xr[64 * j]; s += (v[j].x * v[j].x + v[j].y * v[j].y) + (v[j].z * v[j].z + v[j].w * v[j].w); }
        const float rstd = 1.f / sqrtf(wave_sum(s) * (1.f / D) + EPS);
#pragma unroll
        for (int j = 0; j < 8; ++j) xr[64 * j] = v[j] * rstd * gv[j];
    }
}

__device__ __forceinline__ float logsig16(float x) { return (fminf(x, 0.f) - __logf(1.f + __expf(-fabsf(x)))) * (1.f / 16.f); }
__device__ __forceinline__ void gla_gate_unit(LAS unsigned char* lds, const int tid, int unit, const bf16_t* __restrict__ hn, const float* __restrict__ ss, const bf16_t* __restrict__ wg, const bf16_t* __restrict__ proj,
                                              const float* __restrict__ wgu, const float* __restrict__ bgate, bf16_t* __restrict__ kdt, float* __restrict__ dch) {
    const int half = unit & 1, bc = unit >> 1, b = bc / NCH, c = bc % NCH;
    const int w = __builtin_amdgcn_readfirstlane(tid >> 6), lane = tid & 63, r16 = lane & 15, q = lane >> 4;
    LAS float* part = (LAS float*)lds;
    LAS float* gl = (LAS float*)(lds + 32768);
    LAS float* rsl = (LAS float*)(lds + 32768 + 4096);
    const size_t tok0 = (size_t)b * SEQ + (size_t)c * CH;
    {
        f32x4 acc[4];
#pragma unroll
        for (int tt = 0; tt < 4; ++tt) acc[tt] = (f32x4){0.f, 0.f, 0.f, 0.f};
        const bf16_t* ap = hn + (tok0 + r16) * D + 256 * w + 8 * q;
        const bf16_t* bp = wg + (size_t)r16 * D + 256 * w + 8 * q;
#pragma unroll
        for (int ks = 0; ks < 8; ++ks) {
            const bf16x8 bfr = *(const bf16x8*)(bp + 32 * ks);
#pragma unroll
            for (int tt = 0; tt < 4; ++tt) { const bf16x8 afr = *(const bf16x8*)(ap + (size_t)(16 * tt) * D + 32 * ks); acc[tt] = __builtin_amdgcn_mfma_f32_16x16x32_bf16(afr, bfr, acc[tt], 0, 0, 0); }
        }
        float rsum = 0.f;
        if (tid < 64) { const f32x4* sp = (const f32x4*)(ss + (tok0 + tid) * 64);
#pragma unroll
            for (int k = 0; k < 8; ++k) { const f32x4 v = sp[k]; rsum += (v.x + v.y) + (v.z + v.w); } }
        __syncthreads();
#pragma unroll
        for (int tt = 0; tt < 4; ++tt)
#pragma unroll
            for (int i = 0; i < 4; ++i) part[(w * 64 + 16 * tt + 4 * q + i) * 16 + r16] = acc[tt][i];
        if (tid < 64) rsl[tid] = 1.f / sqrtf(rsum * (1.f / D) + EPS);
        __syncthreads();
#pragma unroll
        for (int e = 0; e < 2; ++e) { const int idx = tid + 512 * e; float sm = 0.f;
#pragma unroll
            for (int ww = 0; ww < 8; ++ww) sm += part[ww * 1024 + idx];
            gl[idx] = sm * rsl[idx >> 4]; }
        __syncthreads();
    }
    const int kc = half * 512 + tid, h = kc >> 8, kk = kc & 255;
    float wv[16];
#pragma unroll
    for (int j = 0; j < 16; ++j) wv[j] = wgu[j * KW + kc];
    const float bias = bgate[kc];
    const bf16_t* kp = proj + tok0 * GPROJ + KW + kc;
    float la[CH]; float total = 0.f;
#pragma unroll
    for (int t = 0; t < CH; ++t) {
        float z = bias;
#pragma unroll
        for (int j4 = 0; j4 < 4; ++j4) { const f32x4 gq = *(const LAS f32x4*)(gl + t * 16 + 4 * j4); z += gq.x * wv[4 * j4] + gq.y * wv[4 * j4 + 1] + gq.z * wv[4 * j4 + 2] + gq.w * wv[4 * j4 + 3]; }
        la[t] = logsig16(z); total += la[t];
    }
    dch[(size_t)bc * KW + kc] = __expf(total);
    bf16_t* outp = kdt + (((size_t)bc * NH + h) * DK + kk) * CH;
    float cum = 0.f;
#pragma unroll
    for (int t8 = 0; t8 < CH; t8 += 8) {
        float r[8];
#pragma unroll
        for (int tt = 0; tt < 8; ++tt) { const int t = t8 + tt; cum += la[t]; r[tt] = bf2f(kp[(size_t)t * GPROJ]) * __expf(total - cum); }
        u32x4 o; o.x = pk2(r[0], r[1]); o.y = pk2(r[2], r[3]); o.z = pk2(r[4], r[5]); o.w = pk2(r[6], r[7]);
        *(u32x4*)(outp + t8) = o;
    }
}

constexpr int GS_KD = 0, GS_KD_STRIDE = 144, GS_Q = 36864, GS_Q_STRIDE = 528, GS_V = GS_Q + 64 * 528, GS_V_STRIDE = 80, GS_D = GS_V + 64 * 80, GS_PART = 77824;
static_assert(GS_D + 1024 <= GS_PART && GS_PART + 2 * 32768 <= LDS_MISC, "gla scan lds");
#define GS_BAR() do { asm volatile("s_waitcnt lgkmcnt(0)" ::: "memory"); __builtin_amdgcn_s_barrier(); asm volatile("" ::: "memory"); } while (0)
__device__ __forceinline__ void gla_scan_unit(LAS unsigned char* lds, const int tid, int unit, const bf16_t* __restrict__ proj, const bf16_t* __restrict__ kdt, const float* __restrict__ dch, bf16_t* __restrict__ o) {
    const int w = __builtin_amdgcn_readfirstlane(tid >> 6), lane = tid & 63, r16 = lane & 15, q = lane >> 4, kq = w & 3, vh = w >> 2;
    const int b = unit >> 6, h = (unit >> 4) & 3, vs = unit & 15;
    f32x4 acc[4];
#pragma unroll
    for (int m = 0; m < 4; ++m) acc[m] = (f32x4){0.f, 0.f, 0.f, 0.f};
    u32x4 pk[4], pq[4], pv; float pd = 0.f;
    auto issue = [&](int c) {
        const bf16_t* ksrc = kdt + ((size_t)(b * NCH + c) * NH + h) * DK * CH;
        const size_t tok0 = (size_t)b * SEQ + (size_t)c * CH;
#pragma unroll
        for (int i = 0; i < 4; ++i) { const int p = tid + 512 * i; pk[i] = *(const u32x4*)(ksrc + (size_t)p * 8); }
#pragma unroll
        for (int i = 0; i < 4; ++i) { const int p = tid + 512 * i, row = p >> 5, pc = p & 31; pq[i] = *(const u32x4*)(proj + (tok0 + row) * GPROJ + h * DK + pc * 8); }
        if (tid < 256) { const int row = tid >> 2, pc = tid & 3; pv = *(const u32x4*)(proj + (tok0 + row) * GPROJ + 2 * KW + h * DV + vs * 32 + pc * 8);
            pd = dch[(size_t)(b * NCH + c) * KW + h * DK + tid]; }
    };
    issue(0);
    GS_BAR();
    for (int c = 0; c < NCH; ++c) {
        const int pbuf = GS_PART + (c & 1) * 32768;
#pragma unroll
        for (int i = 0; i < 4; ++i) { const int p = tid + 512 * i, row = p >> 3, pc = p & 7; *(LAS u32x4*)(lds + GS_KD + row * GS_KD_STRIDE + pc * 16) = pk[i]; }
#pragma unroll
        for (int i = 0; i < 4; ++i) { const int p = tid + 512 * i, row = p >> 5, pc = p & 31; *(LAS u32x4*)(lds + GS_Q + row * GS_Q_STRIDE + pc * 16) = pq[i]; }
        if (tid < 256) { const int row = tid >> 2, pc = tid & 3; *(LAS u32x4*)(lds + GS_V + row * GS_V_STRIDE + pc * 16) = pv; *(LAS float*)(lds + GS_D + tid * 4) = pd; }
        GS_BAR();
        if (c + 1 < NCH) issue(c + 1);
#pragma unroll
        for (int m = 0; m < 4; ++m) { const f32x4 dv = *(const LAS f32x4*)(lds + GS_D + (64 * kq + 16 * m + 4 * q) * 4); acc[m] = acc[m] * dv; }
#pragma unroll
        for (int ks = 0; ks < 2; ++ks) {
            bf16x8 bV;
#pragma unroll
            for (int j = 0; j < 8; ++j) bV[j] = (short)*(const LAS unsigned short*)(lds + GS_V + (32 * ks + 8 * q + j) * GS_V_STRIDE + (16 * vh + r16) * 2);
#pragma unroll
            for (int m = 0; m < 4; ++m) { const bf16x8 a = *(const LAS bf16x8*)(lds + GS_KD + (64 * kq + 16 * m + r16) * GS_KD_STRIDE + (32 * ks + 8 * q) * 2);
                acc[m] = __builtin_amdgcn_mfma_f32_16x16x32_bf16(a, bV, acc[m], 0, 0, 0); }
        }
        f32x4 oacc[4];
#pragma unroll
        for (int tt = 0; tt < 4; ++tt) oacc[tt] = (f32x4){0.f, 0.f, 0.f, 0.f};
#pragma unroll
        for (int mp = 0; mp < 2; ++mp) {
            union { u32x4 u; bf16x8 v; } bs;
            bs.u.x = pk2(acc[2 * mp][0], acc[2 * mp][1]); bs.u.y = pk2(acc[2 * mp][2], acc[2 * mp][3]);
            bs.u.z = pk2(acc[2 * mp + 1][0], acc[2 * mp + 1][1]); bs.u.w = pk2(acc[2 * mp + 1][2], acc[2 * mp + 1][3]);
#pragma unroll
            for (int tt = 0; tt < 4; ++tt) {
                union { u32x4 u; bf16x8 v; } a;
                const LAS unsigned char* qp = lds + GS_Q + (16 * tt + r16) * GS_Q_STRIDE + (64 * kq + 32 * mp + 4 * q) * 2;
                const u32x2 lo = *(const LAS u32x2*)(qp), hi = *(const LAS u32x2*)(qp + 32);
                a.u.x = lo.x; a.u.y = lo.y; a.u.z = hi.x; a.u.w = hi.y;
                oacc[tt] = __builtin_amdgcn_mfma_f32_16x16x32_bf16(a.v, bs.v, oacc[tt], 0, 0, 0);
            }
        }
#pragma unroll
        for (int tt = 0; tt < 4; ++tt) *(LAS f32x4*)(lds + pbuf + ((((vh * 4 + kq) * 4 + tt) * 64 + lane) * 16)) = oacc[tt];
        GS_BAR();
        {
            f32x4 sm = *(const LAS f32x4*)(lds + pbuf + ((((vh * 4 + 0) * 4 + kq) * 64 + lane) * 16));
#pragma unroll
            for (int k2 = 1; k2 < 4; ++k2) sm = sm + *(const LAS f32x4*)(lds + pbuf + ((((vh * 4 + k2) * 4 + kq) * 64 + lane) * 16));
            const size_t tok0 = (size_t)b * SEQ + (size_t)c * CH;
#pragma unroll
            for (int i = 0; i < 4; ++i) {
                const unsigned wv = pk2(sm[i] * 0.0625f, 0.f);
                o[(tok0 + 16 * kq + 4 * q + i) * VW + h * DV + vs * 32 + 16 * vh + r16] = (bf16_t)(wv & 0xffffu);
            }
        }
    }
}

__device__ __forceinline__ void gla_onorm_rows(const bf16_t* __restrict__ o, const bf16_t* __restrict__ proj, const float* __restrict__ onorm, bf16_t* __restrict__ y, int gw, int NGW, int lane) {
    const f32x4 g0 = *(const f32x4*)(onorm + 8 * lane), g1 = *(const f32x4*)(onorm + 8 * lane + 4);
    const float gg[8] = {g0.x, g0.y, g0.z, g0.w, g1.x, g1.y, g1.z, g1.w};
    for (int m0 = gw; m0 < M; m0 += 2 * NGW) {
        u32x4 ov[2][4], rv[2][4];
#pragma unroll
        for (int e = 0; e < 2; ++e) { const int m = m0 + e * NGW; if (m < M) {
            const u32x4* op = (const u32x4*)(o + (size_t)m * VW) + lane; const u32x4* rp = (const u32x4*)(proj + (size_t)m * GPROJ + 2 * KW + VW) + lane;
#pragma unroll
            for (int hh = 0; hh < 4; ++hh) { ov[e][hh] = op[64 * hh]; rv[e][hh] = rp[64 * hh]; } } }
#pragma unroll
        for (int e = 0; e < 2; ++e) { const int m = m0 + e * NGW; if (m < M) {
            u32x4* yp = (u32x4*)(y + (size_t)m * VW) + lane;
#pragma unroll
            for (int hh = 0; hh < 4; ++hh) {
                const u32x4 ovv = ov[e][hh], rvv = rv[e][hh];
                const float x[8] = {bflo(ovv.x), bfhi(ovv.x), bflo(ovv.y), bfhi(ovv.y), bflo(ovv.z), bfhi(ovv.z), bflo(ovv.w), bfhi(ovv.w)};
                const float r[8] = {bflo(rvv.x), bfhi(rvv.x), bflo(rvv.y), bfhi(rvv.y), bflo(rvv.z), bfhi(rvv.z), bflo(rvv.w), bfhi(rvv.w)};
                float sq = 0.f;
#pragma unroll
                for (int j = 0; j < 8; ++j) sq += x[j] * x[j];
                const float rstd = 1.f / sqrtf(wave_sum(sq) * (1.f / DV) + EPS);
                float z[8];
#pragma unroll
                for (int j = 0; j < 8; ++j) z[j] = x[j] * rstd * gg[j] * (r[j] / (1.f + __expf(-r[j])));
                u32x4 wv; wv.x = pk2(z[0], z[1]); wv.y = pk2(z[2], z[3]); wv.z = pk2(z[4], z[5]); wv.w = pk2(z[6], z[7]);
                yp[64 * hh] = wv;
            } } }
    }
}

constexpr int S5_BBT = 0, S5_AR = 4096, S5_AI = 4352, S5_PR = 4608, S5_PI = 4864, S5_ESEG = 5120, S5_WAVE = 9216, S5_WAVE_BYTES = 12288;
static_assert(S5_WAVE + 8 * S5_WAVE_BYTES <= 131072, "s5 lds");
__device__ __forceinline__ float gelu_tanh(float x) { const float z = 0.7978845608028654f * (x + 0.044715f * x * x * x); const float e = __expf(2.f * z); return 0.5f * x * (2.f - 2.f / (e + 1.f)); }
__device__ __forceinline__ void s5_scan_unit(LAS unsigned char* lds, const int tid, int unit, const float* __restrict__ ug, const float* __restrict__ lam_re, const float* __restrict__ lam_im, const float* __restrict__ log_dt,
                                             const float* __restrict__ b_re, const float* __restrict__ b_im, const float* __restrict__ c_re, const float* __restrict__ c_im, const float* __restrict__ dsk, bf16_t* __restrict__ ys) {
    const int w = __builtin_amdgcn_readfirstlane(tid >> 6), lane = tid & 63, r16 = lane & 15, q = lane >> 4;
    const int b = unit >> 6, g = unit & 63;
    __syncthreads();
    if (tid < 64) {
        const int n = tid;
        const float lr = fminf(lam_re[g * S5N + n], -1e-4f), li = lam_im[g * S5N + n], dt = expf(log_dt[g]);
        const float mag = expf(lr * dt), ang = li * dt;
        const float kf = rintf(ang * 0.15915494309189535f); const float rr = fmaf(-kf, 6.2831854820251465f, ang); const float red = fmaf(-kf, -1.7484555e-7f, rr);
        const float cs = cosf(red), sn = sinf(red);
        const float are = mag * cs, aim = mag * sn;
        const float den = lr * lr + li * li, nr = are - 1.f;
        const float fre = (nr * lr + aim * li) / den, fim = (aim * lr - nr * li) / den;
        *(LAS float*)(lds + S5_AR + 4 * n) = are; *(LAS float*)(lds + S5_AI + 4 * n) = aim;
        float pr = are, pi = aim;
#pragma unroll
        for (int s = 0; s < 8; ++s) { const float t0 = pr * pr - pi * pi, t1 = 2.f * pr * pi; pr = t0; pi = t1; }
        *(LAS float*)(lds + S5_PR + 4 * n) = pr; *(LAS float*)(lds + S5_PI + 4 * n) = pi;
        const float* brp = b_re + ((size_t)g * S5N + n) * 16; const float* bip = b_im + ((size_t)g * S5N + n) * 16;
        LAS bf16_t* bbt = (LAS bf16_t*)(lds + S5_BBT);
#pragma unroll
        for (int c = 0; c < 16; c += 2) {
            const float br0 = brp[c], bi0 = bip[c], br1 = brp[c + 1], bi1 = bip[c + 1];
            *(LAS unsigned*)(bbt + n * 16 + c) = pk2(fre * br0 - fim * bi0, fre * br1 - fim * bi1);
            *(LAS unsigned*)(bbt + (64 + n) * 16 + c) = pk2(fre * bi0 + fim * br0, fre * bi1 + fim * br1);
        }
    }
    __syncthreads();
    bf16x8 bB[8];
#pragma unroll
    for (int j = 0; j < 8; ++j) { if (q < 2) bB[j] = *(const LAS bf16x8*)(lds + S5_BBT + (16 * j + r16) * 32 + q * 16); else bB[j] = (bf16x8){0, 0, 0, 0, 0, 0, 0, 0}; }
    bf16x8 bC[4];
#pragma unroll
    for (int ks = 0; ks < 4; ++ks) {
        const int n0 = 16 * ks + 4 * q;
        const f32x4 cr = *(const f32x4*)(c_re + ((size_t)g * 16 + r16) * S5N + n0), ci = *(const f32x4*)(c_im + ((size_t)g * 16 + r16) * S5N + n0);
        union { u32x4 u; bf16x8 v; } t; t.u.x = pk2(cr.x, -ci.x); t.u.y = pk2(cr.y, -ci.y); t.u.z = pk2(cr.z, -ci.z); t.u.w = pk2(cr.w, -ci.w);
        bC[ks] = t.v;
    }
    const float dk = dsk[g * 16 + r16];
    const float are = *(const LAS float*)(lds + S5_AR + 4 * lane), aim = *(const LAS float*)(lds + S5_AI + 4 * lane);
    LAS float* bu = (LAS float*)(lds + S5_WAVE + w * S5_WAVE_BYTES);
    LAS unsigned* xs = (LAS unsigned*)(lds + S5_WAVE + w * S5_WAVE_BYTES + 8192);
    const float* useg = ug + ((size_t)(b * S5G + g) * SEQ + 256 * w) * 16;
    float xr = 0.f, xi = 0.f;
#pragma unroll 1
    for (int pass = 0; pass < 2; ++pass) {
        if (pass == 1) {
            *(LAS float*)(lds + S5_ESEG + (w * 64 + lane) * 8) = xr; *(LAS float*)(lds + S5_ESEG + (w * 64 + lane) * 8 + 4) = xi;
            __syncthreads();
            const float pr = *(const LAS float*)(lds + S5_PR + 4 * lane), pi = *(const LAS float*)(lds + S5_PI + 4 * lane);
            float cr = 0.f, ci = 0.f;
            for (int ww = 0; ww < w; ++ww) { const float er = *(const LAS float*)(lds + S5_ESEG + (ww * 64 + lane) * 8), ei = *(const LAS float*)(lds + S5_ESEG + (ww * 64 + lane) * 8 + 4);
                const float t0 = pr * cr - pi * ci + er, t1 = pr * ci + pi * cr + ei; cr = t0; ci = t1; }
            xr = cr; xi = ci;
        }
        f32x4 nu0 = (f32x4){0.f, 0.f, 0.f, 0.f}, nu1 = nu0; float nuv[4] = {0.f, 0.f, 0.f, 0.f};
        if (q < 2) { nu0 = *(const f32x4*)(useg + r16 * 16 + 8 * q); nu1 = *(const f32x4*)(useg + r16 * 16 + 8 * q + 4); }
        if (pass == 1) {
#pragma unroll
            for (int i = 0; i < 4; ++i) nuv[i] = useg[(4 * q + i) * 16 + r16];
        }
#pragma unroll 1
        for (int sc = 0; sc < 16; ++sc) {
            union { u32x4 u; bf16x8 v; } a;
            a.u.x = pk2(nu0.x, nu0.y); a.u.y = pk2(nu0.z, nu0.w); a.u.z = pk2(nu1.x, nu1.y); a.u.w = pk2(nu1.z, nu1.w);
            float uv[4];
#pragma unroll
            for (int i = 0; i < 4; ++i) uv[i] = nuv[i];
            if (sc + 1 < 16) {
                const float* up = useg + (size_t)(16 * (sc + 1)) * 16;
                if (q < 2) { nu0 = *(const f32x4*)(up + r16 * 16 + 8 * q); nu1 = *(const f32x4*)(up + r16 * 16 + 8 * q + 4); }
                if (pass == 1) {
#pragma unroll
                    for (int i = 0; i < 4; ++i) nuv[i] = up[(4 * q + i) * 16 + r16];
                }
            }
#pragma unroll
            for (int j = 0; j < 4; ++j) {
                const f32x4 rr = __builtin_amdgcn_mfma_f32_16x16x32_bf16(a.v, bB[j], (f32x4){0.f, 0.f, 0.f, 0.f}, 0, 0, 0);
                const f32x4 ri = __builtin_amdgcn_mfma_f32_16x16x32_bf16(a.v, bB[j + 4], (f32x4){0.f, 0.f, 0.f, 0.f}, 0, 0, 0);
#pragma unroll
                for (int i = 0; i < 4; ++i) *(LAS f32x2*)(bu + ((4 * q + i) * 64 + 16 * j + r16) * 2) = (f32x2){rr[i], ri[i]};
            }
            LDS_WAIT(); asm volatile("" ::: "memory");
            if (pass == 0) {
#pragma unroll
                for (int t = 0; t < 16; ++t) { const f32x2 bb = *(const LAS f32x2*)(bu + (t * 64 + lane) * 2); const float br = bb.x, bi = bb.y;
                    const float t0 = are * xr - aim * xi + br, t1 = are * xi + aim * xr + bi; xr = t0; xi = t1; }
            } else {
#pragma unroll
                for (int t = 0; t < 16; ++t) { const f32x2 bb = *(const LAS f32x2*)(bu + (t * 64 + lane) * 2); const float br = bb.x, bi = bb.y;
                    const float t0 = are * xr - aim * xi + br, t1 = are * xi + aim * xr + bi; xr = t0; xi = t1;
                    xs[t * 64 + lane] = pk2(xr, xi); }
                LDS_WAIT(); asm volatile("" ::: "memory");
                f32x4 ya = (f32x4){0.f, 0.f, 0.f, 0.f};
#pragma unroll
                for (int ks = 0; ks < 4; ++ks) { const bf16x8 xa = *(const LAS bf16x8*)((const LAS unsigned char*)xs + r16 * 256 + (32 * ks + 8 * q) * 2);
                    ya = __builtin_amdgcn_mfma_f32_16x16x32_bf16(xa, bC[ks], ya, 0, 0, 0); }
                const size_t tok0 = (size_t)b * SEQ + 256 * w + 16 * sc;
#pragma unroll
                for (int i = 0; i < 4; ++i) { const float yv = gelu_tanh(ya[i] + dk * uv[i]);
                    ys[(tok0 + 4 * q + i) * S5W + g * 16 + r16] = (bf16_t)(pk2(yv, 0.f) & 0xffffu); }
            }
            LDS_WAIT(); asm volatile("" ::: "memory");
        }
    }
}

#define XB_TMO      128
#define XB_XCNT(j)  (256  + 64 * (j))
#define XB_XSUB(j)  (1280 + 64 * (j))
#define XB_XGEN(j)  (2304 + 64 * (j))
#define XB_TOP      3328
#define XB_TOPGEN   3392
#define XCD_BAR_WORDS 3456
#define XB_SPIN_CAP (1u << 20)
__device__ __forceinline__ unsigned xb_ld(unsigned* p)              { return __hip_atomic_load(p, __ATOMIC_RELAXED, __HIP_MEMORY_SCOPE_AGENT); }
__device__ __forceinline__ unsigned xb_add(unsigned* p, unsigned v) { return __hip_atomic_fetch_add(p, v, __ATOMIC_RELAXED, __HIP_MEMORY_SCOPE_AGENT); }
__device__ __forceinline__ unsigned xb_xcc_id() { return (unsigned)__builtin_amdgcn_s_getreg((3 << 11) | 20) & 0xFu; }
#define XB_SPIN(cond, bar) do { unsigned _sp = 0; while (cond) { __builtin_amdgcn_s_sleep(1); \
    if ((++_sp & 255u) == 0u) { if (xb_ld(&(bar)[XB_TMO])) break; if (_sp > XB_SPIN_CAP) { atomicAdd(&(bar)[XB_TMO], 1u); break; } } } } while (0)
__device__ __forceinline__ void xcd_barrier_post(unsigned* bar) { if (threadIdx.x == 0) (void)xb_add(&bar[XB_XCNT(xb_xcc_id())], 1u); }
__device__ __forceinline__ void xcd_barrier_complete(unsigned* bar, unsigned x, unsigned& nloc, unsigned& nx) {
    const unsigned G = gridDim.x;
    unsigned sum, cnt, mine, sp = 0u;
    for (;;) {
        sum = 0u; cnt = 0u; mine = 0u;
#pragma unroll
        for (unsigned j = 0; j < 16; ++j) { const unsigned c = xb_ld(&bar[XB_XCNT(j)]); sum += c; cnt += (c > 0u) ? 1u : 0u; mine = (j == x) ? c : mine; }
        if (sum == G) break;
        __builtin_amdgcn_s_sleep(1);
        if ((++sp & 255u) == 0u) { if (xb_ld(&bar[XB_TMO])) break; if (sp > XB_SPIN_CAP) { atomicAdd(&bar[XB_TMO], 1u); break; } }
    }
    nloc = mine > 0u ? mine : 1u; nx = cnt > 0u ? cnt : 1u;
}
__device__ __forceinline__ void xcd_barrier(unsigned* bar, volatile LAS unsigned* st) {
    asm volatile("s_waitcnt vmcnt(0)" ::: "memory");
    __syncthreads();
    if (threadIdx.x == 0) {
        const unsigned x = xb_xcc_id();
        __builtin_amdgcn_s_waitcnt(0);
        unsigned nloc = st[0], nx = st[1];
        if (nloc == 0u) { xcd_barrier_complete(bar, x, nloc, nx); st[0] = nloc; st[1] = nx; }
        const unsigned old = xb_add(&bar[XB_XSUB(x)], 1u);
        const unsigned gen = old / nloc;
        if (old + 1u == (gen + 1u) * nloc) {
            __builtin_amdgcn_fence(__ATOMIC_RELEASE, "agent");
            asm volatile("s_waitcnt vmcnt(0)" ::: "memory");
            const unsigned og = xb_add(&bar[XB_TOP], 1u);
            const unsigned tg = og / nx;
            if (og + 1u == (tg + 1u) * nx) xb_add(&bar[XB_TOPGEN], 1u);
            else XB_SPIN(xb_ld(&bar[XB_TOPGEN]) == tg, bar);
            __builtin_amdgcn_fence(__ATOMIC_ACQUIRE, "agent");
            xb_add(&bar[XB_XGEN(x)], 1u);
            asm volatile("s_waitcnt vmcnt(0)" ::: "memory");
        } else {
            XB_SPIN(xb_ld(&bar[XB_XGEN(x)]) == gen, bar);
            __builtin_amdgcn_fence(__ATOMIC_ACQUIRE, "agent");
            asm volatile("s_waitcnt vmcnt(0)" ::: "memory");
        }
    }
    __syncthreads();
}

struct Args { const float* in[22]; float* out; unsigned char* ws; int ph_lo, ph_hi; };
constexpr int PH_PER_LAYER = 9, PH_FINAL = 1 + DEPTH * PH_PER_LAYER, PH_END = PH_FINAL + 1;

typedef const Args __attribute__((address_space(4)))* ArgsP;
__device__ __forceinline__ ArgsP launder_args() { ArgsP p = (ArgsP)__builtin_amdgcn_kernarg_segment_ptr(); asm volatile("" : "+s"(p)); return p; }
__global__ void __launch_bounds__(NTHREADS, 2) fwd_kernel(Args args_unused) {
    extern __shared__ __attribute__((aligned(16))) unsigned char lds_raw[];
    LAS unsigned char* lds = (LAS unsigned char*)lds_raw;
    int lo, hi; { ArgsP a = launder_args(); lo = a->ph_lo; hi = a->ph_hi; }
    if (threadIdx.x < 16) ((LAS unsigned*)(lds + LDS_MISC))[threadIdx.x] = 0u;
    __syncthreads();
    if (hi - lo > 1) {
        { ArgsP a = launder_args(); xcd_barrier_post((unsigned*)(a->ws + WS_CTL)); }
        cg::this_grid().sync();
    }
#define PH_LOCALS int tid = threadIdx.x; asm volatile("" : "+v"(tid)); int bx = blockIdx.x; asm volatile("" : "+s"(bx)); int G = gridDim.x; asm volatile("" : "+s"(G)); \
    const int lane = tid & 63, wave = __builtin_amdgcn_readfirstlane(tid >> 6), gw = bx * NWAVES + wave, NGW = G * NWAVES; (void)lane; (void)wave; (void)gw; (void)NGW; ArgsP a = launder_args();

#define PH_RUN(id) (lo <= (id) && (id) < hi)
#define PH_SEAM(id) do { if ((id) + 1 < hi) { ArgsP a_ = launder_args(); xcd_barrier((unsigned*)(a_->ws + WS_CTL), (volatile LAS unsigned*)(lds + LDS_MISC)); } } while (0)
#define WSP(T, off) ((T*)(a->ws + (off)))

    if (PH_RUN(0)) {
        PH_LOCALS unsigned char* ws = a->ws;
        LAS float* scr = (LAS float*)(lds + wave * 16640);
        constexpr int GIN_NB = (GIN + 63) / 64; constexpr int I_GIN = (D / 64) * GIN_NB, I_GOUT = (VW / 64) * (D / 64), I_SIN = (D / 64) * (S5W / 64), I_SOUT = (S5W / 64) * (2 * D / 64), I_UP = (D / 64) * (FF / 64), I_DN = (FF / 64) * (D / 64);
        constexpr int NITEMS = 2 * I_GIN + 2 * I_GOUT + 2 * I_SIN + 2 * I_SOUT + 4 * I_UP + 4 * I_DN;
        for (int rep = 0; rep < ((PROBE_MASK & 2) ? 2 : 1); ++rep)
        for (int it = gw; it < NITEMS; it += NGW) {
            int r = it;
            if (r < 2 * I_GIN) { const int j = r / I_GIN; r %= I_GIN; const int nnb = GIN_NB;
                tr_item(a->in[2] + (size_t)j * D * GIN, D, GIN, (bf16_t*)(ws + WS_WGIN) + (size_t)j * GIN_PAD * D, scr, r / nnb, r % nnb, lane, false, a->in[1] + (size_t)j * D); continue; } r -= 2 * I_GIN;
            if (r < 2 * I_GOUT) { const int j = r / I_GOUT; r %= I_GOUT; const int nnb = D / 64;
                tr_item(a->in[6] + (size_t)j * VW * D, VW, D, (bf16_t*)(ws + WS_WGOUT) + (size_t)j * D * VW, scr, r / nnb, r % nnb, lane, false, nullptr); continue; } r -= 2 * I_GOUT;
            if (r < 2 * I_SIN) { const int j = r / I_SIN; r %= I_SIN; const int nnb = S5W / 64;
                tr_item(a->in[8] + (size_t)j * D * S5W, D, S5W, (bf16_t*)(ws + WS_WSIN) + (size_t)j * S5W * D, scr, r / nnb, r % nnb, lane, false, a->in[7] + (size_t)j * D); continue; } r -= 2 * I_SIN;
            if (r < 2 * I_SOUT) { const int j = r / I_SOUT; r %= I_SOUT; const int nnb = 2 * D / 64;
                tr_item(a->in[17] + (size_t)j * S5W * 2 * D, S5W, 2 * D, (bf16_t*)(ws + WS_WSOUT) + (size_t)j * 2 * D * S5W, scr, r / nnb, r % nnb, lane, true, nullptr); continue; } r -= 2 * I_SOUT;
            if (r < 4 * I_UP) { const int j = r / I_UP; r %= I_UP; const int nnb = FF / 64;
                tr_item(a->in[19] + (size_t)j * D * FF, D, FF, (bf16_t*)(ws + WS_WUP) + (size_t)j * FF * D, scr, r / nnb, r % nnb, lane, false, a->in[18] + (size_t)j * D); continue; } r -= 4 * I_UP;
            { const int j = r / I_DN; r %= I_DN; const int nnb = D / 64;
                tr_item(a->in[20] + (size_t)j * FF * D, FF, D, (bf16_t*)(ws + WS_WDN) + (size_t)j * D * FF, scr, r / nnb, r % nnb, lane, false, nullptr); }
        }
        prep_rows(a->in[0], WSP(bf16_t, WS_HN), WSP(float, WS_SS), gw, NGW, lane);
        PH_SEAM(0);
    }

#pragma unroll 1
    for (int layer = 0; layer < DEPTH; ++layer) {
        const int pb = 1 + layer * PH_PER_LAYER, j = layer >> 1;
        if ((layer & 1) == 0) {
            if (PH_RUN(pb + 1)) {
                PH_LOCALS
                pg8::Gemm gm{WSP(const bf16_t, WS_HN), WSP(const bf16_t, WS_WGIN) + (size_t)j * GIN_PAD * D};
                pg8::rstd_prestep<GPROJ>(lds, tid, G, bx, WSP(const float, WS_SS), 32);
                pg8::EpiProj E{WSP(bf16_t, WS_PROJ), (const LAS float*)(lds + LDS_RSTD)};
                pg8::gemm_phase<pg8::EpiProj, GPROJ, D>(lds, tid, gm, G, bx, E);
                PH_SEAM(pb + 1);
            }
            if (PH_RUN(pb + 2)) {
                PH_LOCALS
                for (int rep = 0; rep < ((PROBE_MASK & 8) ? 2 : 1); ++rep)
                for (int u = bx; u < BATCH * NCH * 2; u += G) gla_gate_unit(lds, tid, u, WSP(const bf16_t, WS_HN), WSP(const float, WS_SS), WSP(const bf16_t, WS_WGIN) + (size_t)j * GIN_PAD * D + (size_t)GPROJ * D, WSP(const bf16_t, WS_PROJ), a->in[3] + (size_t)j * 16 * KW, a->in[4] + (size_t)j * KW, WSP(bf16_t, WS_KDT), WSP(float, WS_DCH));
                PH_SEAM(pb + 2);
            }
            if (PH_RUN(pb + 3)) {
                PH_LOCALS
                for (int rep = 0; rep < ((PROBE_MASK & 16) ? 2 : 1); ++rep)
                for (int u0 = bx; u0 < BATCH * NH * 16; u0 += G) { const int u = (G == 256) ? (u0 & 7) * 32 + (u0 >> 3) : u0; gla_scan_unit(lds, tid, u, WSP(const bf16_t, WS_PROJ), WSP(const bf16_t, WS_KDT), WSP(const float, WS_DCH), WSP(bf16_t, WS_O)); __syncthreads(); }
                PH_SEAM(pb + 3);
            }
            if (PH_RUN(pb + 4)) { PH_LOCALS for (int rep = 0; rep < ((PROBE_MASK & 8) ? 2 : 1); ++rep) gla_onorm_rows(WSP(const bf16_t, WS_O), WSP(const bf16_t, WS_PROJ), a->in[5] + (size_t)j * DV, WSP(bf16_t, WS_Y), gw, NGW, lane); PH_SEAM(pb + 4); }
            if (PH_RUN(pb + 5)) {
                PH_LOCALS
                pg8::Gemm gm{WSP(const bf16_t, WS_Y), WSP(const bf16_t, WS_WGOUT) + (size_t)j * D * VW};
                pg8::EpiResid E{layer == 0 ? a->in[0] : a->out, a->out, WSP(bf16_t, WS_HN), WSP(float, WS_SS)};
                pg8::gemm_phase<pg8::EpiResid, D, VW>(lds, tid, gm, G, bx, E);
                PH_SEAM(pb + 5);
            }
        } else {
            if (PH_RUN(pb + 1)) {
                PH_LOCALS
                pg8::Gemm gm{WSP(const bf16_t, WS_HN), WSP(const bf16_t, WS_WSIN) + (size_t)j * S5W * D};
                pg8::rstd_prestep<S5W>(lds, tid, G, bx, WSP(const float, WS_SS), 32);
                pg8::EpiU E{WSP(float, WS_UG), (const LAS float*)(lds + LDS_RSTD)};
                pg8::gemm_phase<pg8::EpiU, S5W, D>(lds, tid, gm, G, bx, E);
                PH_SEAM(pb + 1);
            }
            if (PH_RUN(pb + 2)) {
                PH_LOCALS
                for (int rep = 0; rep < ((PROBE_MASK & 32) ? 2 : 1); ++rep)
                for (int u0 = bx; u0 < BATCH * S5G; u0 += G) { const int u = (G == 256) ? (u0 & 7) * 32 + (u0 >> 3) : u0;
                    s5_scan_unit(lds, tid, u, WSP(const float, WS_UG), a->in[9] + (size_t)j * S5G * S5N, a->in[10] + (size_t)j * S5G * S5N, a->in[11] + (size_t)j * S5G, a->in[12] + (size_t)j * S5G * S5N * 16, a->in[13] + (size_t)j * S5G * S5N * 16,
                                 a->in[14] + (size_t)j * S5G * 16 * S5N, a->in[15] + (size_t)j * S5G * 16 * S5N, a->in[16] + (size_t)j * S5W, WSP(bf16_t, WS_YS)); }
                PH_SEAM(pb + 2);
            }
            if (PH_RUN(pb + 3)) {
                PH_LOCALS
                pg8::Gemm gm{WSP(const bf16_t, WS_YS), WSP(const bf16_t, WS_WSOUT) + (size_t)j * 2 * D * S5W};
                pg8::EpiGlu E{a->out, a->out, WSP(bf16_t, WS_HN), WSP(float, WS_SS)};
                pg8::gemm_phase<pg8::EpiGlu, 2 * D, S5W>(lds, tid, gm, G, bx, E);
                PH_SEAM(pb + 3);
            }
        }
        if (PH_RUN(pb + 7)) {
            PH_LOCALS
            pg8::Gemm gm{WSP(const bf16_t, WS_HN), WSP(const bf16_t, WS_WUP) + (size_t)layer * FF * D};
            pg8::rstd_prestep<FF>(lds, tid, G, bx, WSP(const float, WS_SS), (layer & 1) ? 64 : 32);
            pg8::EpiRelu2 E{WSP(bf16_t, WS_A), (const LAS float*)(lds + LDS_RSTD)};
            if (PROBE_MASK & 128) pg8::gemm_phase<pg8::EpiRelu2, FF, D>(lds, tid, gm, G, bx, E);
            pg8::gemm_phase<pg8::EpiRelu2, FF, D>(lds, tid, gm, G, bx, E);
            PH_SEAM(pb + 7);
        }
        if (PH_RUN(pb + 8)) {
            PH_LOCALS
            pg8::Gemm gm{WSP(const bf16_t, WS_A), WSP(const bf16_t, WS_WDN) + (size_t)layer * D * FF};
            pg8::EpiResid E{a->out, a->out, WSP(bf16_t, WS_HN), WSP(float, WS_SS)};
            pg8::gemm_phase<pg8::EpiResid, D, FF, true>(lds, tid, gm, G, bx, E);
            PH_SEAM(pb + 8);
        }
    }
    if (PROBE_MASK & 1) { for (int i = 0; i < 32; ++i) PH_SEAM(0); }
    if (PH_RUN(PH_FINAL)) { PH_LOCALS norm_rows_f32(a->out, a->in[21], gw, NGW, lane); }
#undef PH_RUN
#undef PH_SEAM
#undef WSP
}

extern "C" void kernel_launch(void* const* d_in, const int* in_sizes, int n_in, void* d_out, int out_size, void* d_ws, size_t ws_size, hipStream_t stream) {
    static int grid = 0;
    if (grid == 0) {
        if (n_in != 22 || out_size != M * D || ws_size < WS_END) { fprintf(stderr, "kernel_launch: unexpected shapes (n_in %d out %d ws %zu, need %zu)\n", n_in, out_size, ws_size, (size_t)WS_END); grid = -1; return; }
        int dev = 0, cus = 0, per_cu = 0;
        (void)hipGetDevice(&dev);
        (void)hipDeviceGetAttribute(&cus, hipDeviceAttributeMultiprocessorCount, dev);
        if (hipFuncSetAttribute((const void*)fwd_kernel, hipFuncAttributeMaxDynamicSharedMemorySize, LDS_BYTES) != hipSuccess) { fprintf(stderr, "kernel_launch: hipFuncSetAttribute failed\n"); grid = -1; return; }
        if (hipOccupancyMaxActiveBlocksPerMultiprocessor(&per_cu, (const void*)fwd_kernel, NTHREADS, LDS_BYTES) != hipSuccess || per_cu < 1) { fprintf(stderr, "kernel_launch: occupancy query says %d\n", per_cu); per_cu = 1; }
        (void)hipGetLastError();
        grid = cus * 1;
        if (grid <= 0) grid = 256;
    }
    if (grid < 0) return;
    (void)hipMemsetAsync((unsigned char*)d_ws + WS_CTL, 0, CTL_BYTES, stream);
    Args a{};
    for (int i = 0; i < 22; ++i) a.in[i] = (const float*)d_in[i];
    a.out = (float*)d_out; a.ws = (unsigned char*)d_ws;
#if MK_MULTI
    for (int ph = 0; ph < PH_END; ++ph) {
        if (ph >= 1 && ph < PH_FINAL) { const int l = (ph - 1) / PH_PER_LAYER, s = (ph - 1) % PH_PER_LAYER; if ((l & 1) && (s == 4 || s == 5)) continue; if (s == 6 || s == 0) continue; }
        a.ph_lo = ph; a.ph_hi = ph + 1;
        hipLaunchKernelGGL(fwd_kernel, dim3(grid), dim3(NTHREADS), LDS_BYTES, stream, a);
    }
#else
    a.ph_lo = 0; a.ph_hi = PH_END;
    void* kargs[] = {&a};
    hipError_t e = hipLaunchCooperativeKernel((const void*)fwd_kernel, dim3(grid), dim3(NTHREADS), kargs, LDS_BYTES, stream);
    if (e != hipSuccess) fprintf(stderr, "kernel_launch: cooperative launch failed: %s (grid %d)\n", hipGetErrorString(e), grid);
#endif
}
```

```cpp
#include <hip/hip_runtime.h>
#include <hip/hip_cooperative_groups.h>
#include <cstdio>
#include <cstdint>
namespace cg = cooperative_groups;

#ifndef MK_MULTI
#define MK_MULTI 0
#endif
#ifndef PROBE_MASK
#define PROBE_MASK 0
#endif

#define LAS __attribute__((address_space(3)))
typedef unsigned short bf16_t;
typedef short bf16x8 __attribute__((ext_vector_type(8)));
typedef float f32x4 __attribute__((ext_vector_type(4)));
typedef float f32x2 __attribute__((ext_vector_type(2)));
typedef unsigned u32x4 __attribute__((ext_vector_type(4)));
typedef unsigned u32x2 __attribute__((ext_vector_type(2)));

constexpr int D = 2048, BATCH = 4, SEQ = 2048, M = BATCH * SEQ, DEPTH = 4;
constexpr int GIN = 6160, GIN_PAD = 6400, GPROJ = 6144;
constexpr int KW = 1024, VW = 2048, DK = 256, DV = 512, NH = 4, CH = 64, NCH = SEQ / CH;
constexpr int S5W = 1024, S5G = 64, S5N = 64;
constexpr int FF = 8192;
constexpr float EPS = 1e-6f;

constexpr size_t MiB = 1u << 20;
constexpr size_t WS_WGIN = 0;
constexpr size_t WS_WGOUT = WS_WGIN + 50 * MiB;
constexpr size_t WS_WSIN = WS_WGOUT + 16 * MiB;
constexpr size_t WS_WSOUT = WS_WSIN + 8 * MiB;
constexpr size_t WS_WUP = WS_WSOUT + 16 * MiB;
constexpr size_t WS_WDN = WS_WUP + 128 * MiB;
constexpr size_t WS_HN = WS_WDN + 128 * MiB;
constexpr size_t WS_Y = WS_HN + 32 * MiB;
constexpr size_t WS_PROJ = WS_Y + 32 * MiB;
constexpr size_t WS_GLOW = WS_PROJ + 96 * MiB;
constexpr size_t WS_KDT = WS_GLOW + 1 * MiB;
constexpr size_t WS_DCH = WS_KDT + 16 * MiB;
constexpr size_t WS_O = WS_DCH + 1 * MiB;
constexpr size_t WS_A = WS_O + 32 * MiB;
constexpr size_t WS_UG = WS_A + 128 * MiB;
constexpr size_t WS_YS = WS_UG + 32 * MiB;
constexpr size_t WS_SS = WS_YS + 16 * MiB;
constexpr size_t WS_CTL = WS_SS + 2 * MiB;
constexpr size_t CTL_BYTES = 65536;
constexpr size_t WS_END = WS_CTL + 1 * MiB;

constexpr int NWAVES = 8, NTHREADS = 512;
constexpr int LDS_BYTES = 147456;
constexpr int LDS_RSTD = 131072;
constexpr int LDS_MISC = LDS_BYTES - 64;

namespace pg8 {
constexpr int BM = 256, BK = 64, HALF = 128, HTB = HALF * BK * 2, STAGE_BYTES = 8 * HTB, NXCD = 8, WGM = 4;
__device__ __forceinline__ int lds_byte(int r, int c) { const int st = (r >> 4) * 2 + (c >> 5), rr = r & 15, cc = c & 31, ob = rr * 64 + cc * 2; return st * 1024 + (ob ^ (((ob >> 9) & 1) << 5)); }
__device__ __forceinline__ void stage_rc(int b, int& R, int& C) { const int st = b / 1024, sb = b % 1024, swz = sb ^ (((sb >> 9) & 1) << 5); R = (st >> 1) * 16 + swz / 64; C = (st & 1) * 32 + (swz % 64) / 2; }
__device__ __forceinline__ int perm32(int rho) { const int n = rho >> 4, i = rho & 15; return 8 * (i >> 2) + 4 * n + (i & 3); }

struct Unit { int pm, pn; };
struct Gemm { const bf16_t* A; const bf16_t* Bt; };

template <int N_> struct StaticOrder {
    static constexpr int nM = ::M / BM, nN = N_ / BM, nwg = nM * nN;
    int G, c;
    __device__ __forceinline__ void init(int G_, int c_) { G = G_; c = c_; }
    __device__ __forceinline__ bool next(int i, Unit& u) const {
        const int L = i * G + c; if (L >= nwg) return false;
        int wgid = L; { constexpr int q = nwg / NXCD, r = nwg % NXCD; const int xcd = wgid % NXCD, off = wgid / NXCD; wgid = (xcd < r ? xcd * (q + 1) : r * (q + 1) + (xcd - r) * q) + off; }
        constexpr int nig = WGM * nN; const int gid = wgid / nig, fm = gid * WGM, gsz = (nM - fm) < WGM ? (nM - fm) : WGM;
        u.pm = fm + ((wgid % nig) % gsz); u.pn = (wgid % nig) / gsz; return true;
    }
};

typedef __bf16 nbf16x2 __attribute__((ext_vector_type(2)));
__device__ __forceinline__ unsigned cvt_pk_bf16(float lo, float hi) { const f32x2 v = {lo, hi}; const nbf16x2 b = __builtin_convertvector(v, nbf16x2); return __builtin_bit_cast(unsigned, b); }

struct EpiProj {
    static constexpr bool PERM = true;
    bf16_t* P; const LAS float* rs;
    __device__ __forceinline__ void operator()(const f32x4 (&acc)[2][2][4][2], const Unit& u, int ui, int wr, int wc, int fr, int fq) const {
        const int row0 = u.pm * BM + wr * 64 + fr, col0 = u.pn * BM + wc * 32 + 8 * fq;
#pragma unroll
        for (int ai = 0; ai < 2; ++ai)
#pragma unroll
            for (int m = 0; m < 4; ++m) { bf16_t* rowp = P + (size_t)(row0 + ai * HALF + m * 16) * GPROJ + col0; const float sc = rs[ui * 256 + wr * 64 + fr + ai * HALF + m * 16];
#pragma unroll
                for (int bj = 0; bj < 2; ++bj) { const f32x4 v0 = acc[ai][bj][m][0] * sc, v1 = acc[ai][bj][m][1] * sc;
                    u32x4 w; w.x = cvt_pk_bf16(v0[0], v0[1]); w.y = cvt_pk_bf16(v0[2], v0[3]); w.z = cvt_pk_bf16(v1[0], v1[1]); w.w = cvt_pk_bf16(v1[2], v1[3]);
                    *(u32x4*)(rowp + bj * HALF) = w; } }
    }
};
struct EpiRelu2 {
    static constexpr bool PERM = true;
    bf16_t* O; const LAS float* rs;
    __device__ __forceinline__ void operator()(const f32x4 (&acc)[2][2][4][2], const Unit& u, int ui, int wr, int wc, int fr, int fq) const {
        const int row0 = u.pm * BM + wr * 64 + fr, col0 = u.pn * BM + wc * 32 + 8 * fq;
#pragma unroll
        for (int ai = 0; ai < 2; ++ai)
#pragma unroll
            for (int m = 0; m < 4; ++m) { bf16_t* rowp = O + (size_t)(row0 + ai * HALF + m * 16) * FF + col0; const float sc = rs[ui * 256 + wr * 64 + fr + ai * HALF + m * 16];
#pragma unroll
                for (int bj = 0; bj < 2; ++bj) { f32x4 v0 = acc[ai][bj][m][0] * sc, v1 = acc[ai][bj][m][1] * sc;
#pragma unroll
                    for (int j = 0; j < 4; ++j) { const float a = fmaxf(v0[j], 0.f), b = fmaxf(v1[j], 0.f); v0[j] = a * a; v1[j] = b * b; }
                    u32x4 w; w.x = cvt_pk_bf16(v0[0], v0[1]); w.y = cvt_pk_bf16(v0[2], v0[3]); w.z = cvt_pk_bf16(v1[0], v1[1]); w.w = cvt_pk_bf16(v1[2], v1[3]);
                    *(u32x4*)(rowp + bj * HALF) = w; } }
    }
};
struct EpiResid {
    static constexpr bool PERM = false;
    const float* base; float* out; bf16_t* hb; float* ss;
    __device__ __forceinline__ void operator()(const f32x4 (&acc)[2][2][4][2], const Unit& u, int ui, int wr, int wc, int fr, int fq) const {
        const int row0 = u.pm * BM + wr * 64 + fr, col0 = u.pn * BM + wc * 32 + 4 * fq;
#pragma unroll
        for (int ai = 0; ai < 2; ++ai)
#pragma unroll
            for (int m = 0; m < 4; ++m) { const int row = row0 + ai * HALF + m * 16; const size_t ro = (size_t)row * D + col0; float sq = 0.f;
#pragma unroll
                for (int bj = 0; bj < 2; ++bj)
#pragma unroll
                    for (int n = 0; n < 2; ++n) { const size_t o = ro + bj * HALF + n * 16; const f32x4 r = *(const f32x4*)(base + o) + acc[ai][bj][m][n]; *(f32x4*)(out + o) = r;
                        sq += (r[0] * r[0] + r[1] * r[1]) + (r[2] * r[2] + r[3] * r[3]);
                        u32x2 w; w.x = cvt_pk_bf16(r[0], r[1]); w.y = cvt_pk_bf16(r[2], r[3]); *(u32x2*)(hb + o) = w; }
                sq += __shfl_xor(sq, 16); sq += __shfl_xor(sq, 32);
                if (fq == 0) ss[(size_t)row * 64 + u.pn * 4 + wc] = sq; }
    }
};
struct EpiU {
    static constexpr bool PERM = false;
    float* ug; const LAS float* rs;
    __device__ __forceinline__ void operator()(const f32x4 (&acc)[2][2][4][2], const Unit& u, int ui, int wr, int wc, int fr, int fq) const {
        const int row0 = u.pm * BM + wr * 64 + fr;
#pragma unroll
        for (int ai = 0; ai < 2; ++ai)
#pragma unroll
            for (int m = 0; m < 4; ++m) { const int row = row0 + ai * HALF + m * 16, b = row / SEQ, t = row % SEQ; const float sc = rs[ui * 256 + wr * 64 + fr + ai * HALF + m * 16];
#pragma unroll
                for (int bj = 0; bj < 2; ++bj)
#pragma unroll
                    for (int n = 0; n < 2; ++n) { const int grp = 16 * u.pn + 8 * bj + 2 * wc + n;
                        *(f32x4*)(ug + ((size_t)(b * S5G + grp) * SEQ + t) * 16 + 4 * fq) = acc[ai][bj][m][n] * sc; } }
    }
};
struct EpiGlu {
    static constexpr bool PERM = false;
    const float* base; float* out; bf16_t* hb; float* ss;
    __device__ __forceinline__ void operator()(const f32x4 (&acc)[2][2][4][2], const Unit& u, int ui, int wr, int wc, int fr, int fq) const {
        const int row0 = u.pm * BM + wr * 64 + fr, col0 = u.pn * HALF + wc * 32 + 4 * fq;
#pragma unroll
        for (int ai = 0; ai < 2; ++ai)
#pragma unroll
            for (int m = 0; m < 4; ++m) { const int row = row0 + ai * HALF + m * 16; const size_t ro = (size_t)row * D + col0; float sq = 0.f;
#pragma unroll
                for (int n = 0; n < 2; ++n) { const size_t o = ro + n * 16; const f32x4 v = acc[ai][0][m][n], gt = acc[ai][1][m][n]; f32x4 r = *(const f32x4*)(base + o);
#pragma unroll
                    for (int j = 0; j < 4; ++j) r[j] += v[j] / (1.f + __expf(-gt[j]));
                    *(f32x4*)(out + o) = r;
                    sq += (r[0] * r[0] + r[1] * r[1]) + (r[2] * r[2] + r[3] * r[3]);
                    u32x2 w; w.x = cvt_pk_bf16(r[0], r[1]); w.y = cvt_pk_bf16(r[2], r[3]); *(u32x2*)(hb + o) = w; }
                sq += __shfl_xor(sq, 16); sq += __shfl_xor(sq, 32);
                if (fq == 0) ss[(size_t)row * 64 + u.pn * 4 + wc] = sq; }
    }
};

template <int N> __device__ __forceinline__ void rstd_prestep(LAS unsigned char* lds, const int tid, const int G_, const int c_, const float* __restrict__ ss, const int nss) {
    StaticOrder<N> S; S.init(G_, c_);
    LAS float* rs = (LAS float*)(lds + LDS_RSTD);
    const int r = tid >> 1, hf = tid & 1, cnt = nss >> 1;
    Unit u;
    for (int i = 0; i < 8; ++i) {
        if (!S.next(i, u)) break;
        const float* p = ss + (size_t)(u.pm * BM + r) * 64 + hf * cnt;
        float sm = 0.f;
        for (int k = 0; k < cnt; k += 4) { const f32x4 v = *(const f32x4*)(p + k); sm += (v.x + v.y) + (v.z + v.w); }
        sm += __shfl_xor(sm, 1);
        if (hf == 0) rs[i * 256 + r] = 1.f / sqrtf(sm * (1.f / D) + EPS);
    }
    __syncthreads();
}

template <class Epi, int N, int K, bool KREV = false, bool ALIGN_EPI = true, bool SP2 = true>
__device__ __forceinline__ void gemm_phase(LAS unsigned char* lds, const int tid, const Gemm g, const int G_, const int c_, const Epi& E) {
    StaticOrder<N> S; S.init(G_, c_);
    const int wid = __builtin_amdgcn_readfirstlane(tid >> 6), lane = tid & 63, wr = wid >> 2, wc = wid & 3, fr = lane & 15, fq = lane >> 4;
    constexpr int nt = K / BK;
    unsigned voffA[2], voffB[2];
#pragma unroll
    for (int i = 0; i < 2; ++i) { int R, C; stage_rc(tid * 16 + i * 8192, R, C); const int Rb = Epi::PERM ? ((R & ~31) + perm32(R & 31)) : R;
        voffA[i] = (unsigned)(R * K + C) * 2u; voffB[i] = (unsigned)(Rb * K + C) * 2u; }
    constexpr long kstep = KREV ? -(long)(BK * 2) : (long)(BK * 2);
    constexpr size_t kfirst = KREV ? (size_t)(K - BK) * 2 : (size_t)0;
    constexpr size_t hstep = (size_t)HALF * K * 2;
    constexpr size_t tstep = 2 * hstep;
    const unsigned ldsw = (unsigned)wid * 1024u;
    const int aoff = lds_byte(wr * 64 + fr, fq * 8), boff = lds_byte(wc * 32 + fr, fq * 8);
#define PG8_SA(b, h) (((b) * 2 + (h)) * HTB)
#define PG8_SB(b, h) ((4 + (b) * 2 + (h)) * HTB)
#define PG8_STAGE(bufoff, gbase, voff) do { _Pragma("unroll") for (int _i = 0; _i < 2; ++_i) \
        __builtin_amdgcn_global_load_lds((const unsigned*)((const char*)(gbase) + (voff)[_i]), (LAS unsigned*)(lds + (bufoff) + ldsw + _i * 8192), 16, 0, 0); } while (0)
#define PG8_LDA(dst, b, h) do { _Pragma("unroll") for (int m = 0; m < 4; ++m) _Pragma("unroll") for (int k = 0; k < 2; ++k) dst[m][k] = *(const LAS bf16x8*)(lds + PG8_SA(b, h) + aoff + m * 2048 + k * 1024); } while (0)
#define PG8_LDB(dst, b, h) do { _Pragma("unroll") for (int n = 0; n < 2; ++n) _Pragma("unroll") for (int k = 0; k < 2; ++k) dst[n][k] = *(const LAS bf16x8*)(lds + PG8_SB(b, h) + boff + n * 2048 + k * 1024); } while (0)
#define PG8_MMA(ai, bj, At, Bt) do { __builtin_amdgcn_s_setprio(1); _Pragma("unroll") for (int m = 0; m < 4; ++m) _Pragma("unroll") for (int n = 0; n < 2; ++n) _Pragma("unroll") for (int k = 0; k < 2; ++k) \
        acc[ai][bj][m][n] = __builtin_amdgcn_mfma_f32_16x16x32_bf16(Bt[n][k], At[m][k], acc[ai][bj][m][n], 0, 0, 0); __builtin_amdgcn_s_setprio(0); } while (0)
#define PG8_WAIT_V(n) asm volatile("s_waitcnt vmcnt(" #n ")" ::: "memory")
#define PG8_WAIT_L(n) asm volatile("s_waitcnt lgkmcnt(" #n ")" ::: "memory")
#define PG8_BAR __builtin_amdgcn_s_barrier()
#define PG8_SCHED __builtin_amdgcn_sched_barrier(0)
    Unit cur, nxt; int ui = 0;
    if (!S.next(0, cur)) return;
    f32x4 acc[2][2][4][2];
#pragma unroll
    for (int a = 0; a < 2; ++a)
#pragma unroll
        for (int b = 0; b < 2; ++b)
#pragma unroll
            for (int m = 0; m < 4; ++m)
#pragma unroll
                for (int n = 0; n < 2; ++n) acc[a][b][m][n] = (f32x4){0.f, 0.f, 0.f, 0.f};
    bf16x8 At[4][2], B0[2][2], B1[2][2];
    const char* cA = (const char*)g.A + (size_t)cur.pm * tstep + kfirst; const char* cB = (const char*)g.Bt + (size_t)cur.pn * tstep + kfirst;
    if constexpr (SP2) {
        PG8_STAGE(PG8_SB(0, 0), cB, voffB); PG8_STAGE(PG8_SB(0, 1), cB + hstep, voffB); PG8_STAGE(PG8_SA(0, 0), cA, voffA); PG8_STAGE(PG8_SA(0, 1), cA + hstep, voffA);
        if (wr == 1) PG8_BAR;
        PG8_WAIT_V(2); PG8_BAR;
        PG8_STAGE(PG8_SB(1, 0), cB + kstep, voffB); PG8_STAGE(PG8_SA(1, 0), cA + kstep, voffA); PG8_STAGE(PG8_SB(1, 1), cB + hstep + kstep, voffB);
        PG8_WAIT_V(6); PG8_BAR;
    } else {
        PG8_STAGE(PG8_SB(0, 0), cB, voffB); PG8_STAGE(PG8_SA(0, 0), cA, voffA); PG8_STAGE(PG8_SB(0, 1), cB + hstep, voffB); PG8_STAGE(PG8_SA(0, 1), cA + hstep, voffA);
        if (wr == 1) PG8_BAR;
        PG8_WAIT_V(4); PG8_BAR;
        PG8_STAGE(PG8_SB(1, 0), cB + kstep, voffB); PG8_STAGE(PG8_SA(1, 0), cA + kstep, voffA); PG8_STAGE(PG8_SB(1, 1), cB + hstep + kstep, voffB);
        PG8_WAIT_V(6); PG8_BAR;
    }
    for (;;) {
        const bool has_next = S.next(ui + 1, nxt);
        const char* nA = has_next ? (const char*)g.A + (size_t)nxt.pm * tstep + kfirst : cA; const char* nB = has_next ? (const char*)g.Bt + (size_t)nxt.pn * tstep + kfirst : cB;
        for (int t = 0; t < nt; t += 2) {
            const bool last = (t == nt - 2);
            const char* a1 = cA + (long)(t + 1) * kstep;
            const char* a2 = last ? nA : cA + (long)(t + 2) * kstep; const char* b2 = last ? nB : cB + (long)(t + 2) * kstep;
            const char* a3 = a2 + kstep; const char* b3 = b2 + kstep;
            if constexpr (SP2) {
            PG8_LDB(B0, 0, 0); PG8_LDB(B1, 0, 1); PG8_SCHED; PG8_LDA(At, 0, 0); PG8_STAGE(PG8_SA(1, 1), a1 + hstep, voffA);
            PG8_WAIT_V(8); PG8_WAIT_L(0); PG8_BAR; PG8_MMA(0, 0, At, B0); PG8_MMA(0, 1, At, B1); PG8_BAR; PG8_SCHED;
            PG8_LDA(At, 0, 1); PG8_STAGE(PG8_SB(0, 0), b2, voffB); PG8_STAGE(PG8_SB(0, 1), b2 + hstep, voffB); PG8_STAGE(PG8_SA(0, 0), a2, voffA);
            PG8_WAIT_V(8); PG8_WAIT_L(0); PG8_BAR; PG8_MMA(1, 0, At, B0); PG8_MMA(1, 1, At, B1); PG8_BAR; PG8_SCHED;
            PG8_LDB(B0, 1, 0); PG8_LDB(B1, 1, 1); PG8_SCHED; PG8_LDA(At, 1, 0); PG8_STAGE(PG8_SA(0, 1), a2 + hstep, voffA);
            PG8_WAIT_V(8); PG8_WAIT_L(0); PG8_BAR; PG8_MMA(0, 0, At, B0); PG8_MMA(0, 1, At, B1); PG8_BAR; PG8_SCHED;
            PG8_LDA(At, 1, 1); PG8_STAGE(PG8_SB(1, 0), b3, voffB); PG8_STAGE(PG8_SB(1, 1), b3 + hstep, voffB); PG8_STAGE(PG8_SA(1, 0), a3, voffA);
            PG8_WAIT_V(8); PG8_WAIT_L(0); PG8_BAR; PG8_MMA(1, 0, At, B0); PG8_MMA(1, 1, At, B1); PG8_BAR; PG8_SCHED;
            } else {
            PG8_LDB(B0, 0, 0); PG8_SCHED; PG8_LDA(At, 0, 0); PG8_STAGE(PG8_SA(1, 1), a1 + hstep, voffA);
            PG8_WAIT_L(8); PG8_BAR; PG8_WAIT_L(0); PG8_MMA(0, 0, At, B0); PG8_BAR; PG8_SCHED;
            PG8_LDB(B1, 0, 1); PG8_STAGE(PG8_SB(0, 0), b2, voffB);
            PG8_BAR; PG8_WAIT_L(0); PG8_MMA(0, 1, At, B1); PG8_BAR;
            PG8_LDA(At, 0, 1); PG8_STAGE(PG8_SA(0, 0), a2, voffA);
            PG8_BAR; PG8_WAIT_L(0); PG8_MMA(1, 0, At, B0); PG8_BAR; PG8_SCHED;
            PG8_STAGE(PG8_SB(0, 1), b2 + hstep, voffB);
            PG8_WAIT_V(6); PG8_BAR; PG8_MMA(1, 1, At, B1); PG8_BAR;
            PG8_LDB(B0, 1, 0); PG8_SCHED; PG8_LDA(At, 1, 0); PG8_STAGE(PG8_SA(0, 1), a2 + hstep, voffA);
            PG8_WAIT_L(8); PG8_BAR; PG8_WAIT_L(0); PG8_MMA(0, 0, At, B0); PG8_BAR; PG8_SCHED;
            PG8_LDB(B1, 1, 1); PG8_STAGE(PG8_SB(1, 0), b3, voffB);
            PG8_BAR; PG8_WAIT_L(0); PG8_MMA(0, 1, At, B1); PG8_BAR;
            PG8_LDA(At, 1, 1); PG8_STAGE(PG8_SA(1, 0), a3, voffA);
            PG8_BAR; PG8_WAIT_L(0); PG8_MMA(1, 0, At, B0); PG8_BAR; PG8_SCHED;
            PG8_STAGE(PG8_SB(1, 1), b3 + hstep, voffB);
            PG8_WAIT_V(6); PG8_BAR; PG8_MMA(1, 1, At, B1); PG8_BAR;
            }
        }
        if constexpr (ALIGN_EPI) { if (wr == 0) PG8_BAR; }
        E(acc, cur, ui, wr, wc, fr, fq);
        if (!has_next) break;
#pragma unroll
        for (int a = 0; a < 2; ++a)
#pragma unroll
            for (int b = 0; b < 2; ++b)
#pragma unroll
                for (int m = 0; m < 4; ++m)
#pragma unroll
                    for (int n = 0; n < 2; ++n) acc[a][b][m][n] = (f32x4){0.f, 0.f, 0.f, 0.f};
        cur = nxt; cA = nA; cB = nB; ++ui;
        if constexpr (ALIGN_EPI) { if (wr == 1) PG8_BAR; }
    }
    PG8_WAIT_V(0);
    if constexpr (!ALIGN_EPI) { if (wr == 0) PG8_BAR; }
    PG8_BAR;
#undef PG8_SA
#undef PG8_SB
#undef PG8_STAGE
#undef PG8_LDA
#undef PG8_LDB
#undef PG8_MMA
#undef PG8_WAIT_V
#undef PG8_WAIT_L
#undef PG8_BAR
#undef PG8_SCHED
}
}

#define LDS_WAIT() asm volatile("s_waitcnt lgkmcnt(0)" ::: "memory")
__device__ __forceinline__ unsigned pk2(float lo, float hi) { return pg8::cvt_pk_bf16(lo, hi); }
__device__ __forceinline__ float bf2f(bf16_t b) { return __uint_as_float(((unsigned)b) << 16); }
__device__ __forceinline__ float bflo(unsigned w) { return __uint_as_float(w << 16); }
__device__ __forceinline__ float bfhi(unsigned w) { return __uint_as_float(w & 0xffff0000u); }
__device__ __forceinline__ float wave_sum(float v) {
#pragma unroll
    for (int o = 1; o < 64; o <<= 1) v += __shfl_xor(v, o);
    return v;
}

__device__ __forceinline__ void tr_item(const float* __restrict__ W, int K, int Nsrc, bf16_t* __restrict__ WT, LAS float* scr, int kb, int nb, int lane, bool glu, const float* __restrict__ gain) {
    const int k0 = 64 * kb, n0 = 64 * nb, c4 = lane & 15, rg = lane >> 4, nn = n0 + 4 * c4; const bool ok = nn < Nsrc;
    const float* src = W + (size_t)(k0 + rg) * Nsrc + (ok ? nn : 0);
    f32x4 v[16];
#pragma unroll
    for (int i = 0; i < 16; ++i) v[i] = *(const f32x4*)(src + (size_t)(4 * i) * Nsrc);
#pragma unroll
    for (int i = 0; i < 16; ++i) { LAS float* d = scr + (4 * i + rg) * 65 + 4 * c4; const float gk = gain ? gain[k0 + 4 * i + rg] : 1.f; const f32x4 x = ok ? v[i] * gk : (f32x4){0.f, 0.f, 0.f, 0.f}; d[0] = x.x; d[1] = x.y; d[2] = x.z; d[3] = x.w; }
    LDS_WAIT(); asm volatile("" ::: "memory");
    int dest0 = n0;
    if (glu) dest0 = (n0 < 2048) ? (n0 / 128) * 256 + (n0 % 128) : ((n0 - 2048) / 128) * 256 + 128 + ((n0 - 2048) % 128);
    const int c = lane & 7;
#pragma unroll
    for (int j = 0; j < 8; ++j) { const int n = (lane >> 3) + 8 * j; const LAS float* s = scr + (8 * c) * 65 + n;
        u32x4 o; o.x = pk2(s[0 * 65], s[1 * 65]); o.y = pk2(s[2 * 65], s[3 * 65]); o.z = pk2(s[4 * 65], s[5 * 65]); o.w = pk2(s[6 * 65], s[7 * 65]);
        *(u32x4*)(WT + (size_t)(dest0 + n) * K + k0 + 8 * c) = o; }
    LDS_WAIT(); asm volatile("" ::: "memory");
}

__device__ __forceinline__ void norm_rows_bf16(const float* __restrict__ src, const float* __restrict__ gain, bf16_t* __restrict__ dst, int gw, int NGW, int lane) {
    f32x4 gv[8];
#pragma unroll
    for (int j = 0; j < 8; ++j) gv[j] = *(const f32x4*)(gain + 4 * lane + 256 * j);
    for (int m = gw; m < M; m += NGW) {
        const f32x4* xr = (const f32x4*)(src + (size_t)m * D) + lane;
        f32x4 v[8]; float s = 0.f;
#pragma unroll
        for (int j = 0; j < 8; ++j) { v[j] = xr[64 * j]; s += (v[j].x * v[j].x + v[j].y * v[j].y) + (v[j].z * v[j].z + v[j].w * v[j].w); }
        const float rstd = 1.f / sqrtf(wave_sum(s) * (1.f / D) + EPS);
        u32x2* o8 = (u32x2*)(dst + (size_t)m * D) + lane;
#pragma unroll
        for (int j = 0; j < 8; ++j) { u32x2 w; w.x = pk2(v[j].x * rstd * gv[j].x, v[j].y * rstd * gv[j].y); w.y = pk2(v[j].z * rstd * gv[j].z, v[j].w * rstd * gv[j].w); o8[64 * j] = w; }
    }
}
__device__ __forceinline__ void prep_rows(const float* __restrict__ src, bf16_t* __restrict__ dst, float* __restrict__ ss, int gw, int NGW, int lane) {
    for (int m = gw; m < M; m += NGW) {
        const f32x4* xr = (const f32x4*)(src + (size_t)m * D) + lane;
        f32x4 v[8]; float s = 0.f;
#pragma unroll
        for (int j = 0; j < 8; ++j) { v[j] = xr[64 * j]; s += (v[j].x * v[j].x + v[j].y * v[j].y) + (v[j].z * v[j].z + v[j].w * v[j].w); }
        s = wave_sum(s);
        u32x2* o8 = (u32x2*)(dst + (size_t)m * D) + lane;
#pragma unroll
        for (int j = 0; j < 8; ++j) { u32x2 w; w.x = pk2(v[j].x, v[j].y); w.y = pk2(v[j].z, v[j].w); o8[64 * j] = w; }
        if (lane < 32) ss[(size_t)m * 64 + lane] = lane == 0 ? s : 0.f;
    }
}
__device__ __forceinline__ void norm_rows_f32(float* __restrict__ io, const float* __restrict__ gain, int gw, int NGW, int lane) {
    f32x4 gv[8];
#pragma unroll
    for (int j = 0; j < 8; ++j) gv[j] = *(const f32x4*)(gain + 4 * lane + 256 * j);
    for (int m0 = gw; m0 < M; m0 += 2 * NGW) {
        f32x4 v[2][8];
#pragma unroll
        for (int e = 0; e < 2; ++e) { const int m = m0 + e * NGW; if (m < M) { const f32x4* xr = (const f32x4*)(io + (size_t)m * D) + lane;
#pragma unroll
            for (int j = 0; j < 8; ++j) v[e][j] = xr[64 * j]; } }
#pragma unroll
        for (int e = 0; e < 2; ++e) { const int m = m0 + e * NGW; if (m < M) { f32x4* xr = (f32x4*)(io + (size_t)m * D) + lane; float s = 0.f;
#pragma unroll
            for (int j = 0; j < 8; ++j) s += (v[e][j].x * v[e][j].x + v[e][j].y * v[e][j].y) + (v[e][j].z * v[e][j].z + v[e][j].w * v[e][j].w);
            const float rstd = 1.f / sqrtf(wave_sum(s) * (1.f / D) + EPS);
#pragma unroll
            for (int j = 0; j < 8; ++j) xr[64 * j] = v[e][j] * rstd * gv[j]; } }
    }
}
__device__ __forceinline__ float logsig16(float x) { return (fminf(x, 0.f) - __logf(1.f + __expf(-fabsf(x)))) * (1.f / 16.f); }
__device__ __forceinline__ void gla_gate_unit(LAS unsigned char* lds, const int tid, int unit, const bf16_t* __restrict__ hn, const float* __restrict__ ss, const bf16_t* __restrict__ wg, const bf16_t* __restrict__ proj,
                                              const float* __restrict__ wgu, const float* __restrict__ bgate, bf16_t* __restrict__ kdt, float* __restrict__ dch) {
    const int half = unit & 1, bc = unit >> 1, b = bc / NCH, c = bc % NCH;
    const int w = __builtin_amdgcn_readfirstlane(tid >> 6), lane = tid & 63, r16 = lane & 15, q = lane >> 4;
    LAS float* part = (LAS float*)lds;
    LAS float* gl = (LAS float*)(lds + 32768);
    LAS float* rsl = (LAS float*)(lds + 32768 + 4096);
    const size_t tok0 = (size_t)b * SEQ + (size_t)c * CH;
    {
        f32x4 acc[4];
#pragma unroll
        for (int tt = 0; tt < 4; ++tt) acc[tt] = (f32x4){0.f, 0.f, 0.f, 0.f};
        const bf16_t* ap = hn + (tok0 + r16) * D + 256 * w + 8 * q;
        const bf16_t* bp = wg + (size_t)r16 * D + 256 * w + 8 * q;
#pragma unroll
        for (int ks = 0; ks < 8; ++ks) {
            const bf16x8 bfr = *(const bf16x8*)(bp + 32 * ks);
#pragma unroll
            for (int tt = 0; tt < 4; ++tt) { const bf16x8 afr = *(const bf16x8*)(ap + (size_t)(16 * tt) * D + 32 * ks); acc[tt] = __builtin_amdgcn_mfma_f32_16x16x32_bf16(afr, bfr, acc[tt], 0, 0, 0); }
        }
        float rsum = 0.f;
        if (tid < 64) { const f32x4* sp = (const f32x4*)(ss + (tok0 + tid) * 64);
#pragma unroll
            for (int k = 0; k < 8; ++k) { const f32x4 v = sp[k]; rsum += (v.x + v.y) + (v.z + v.w); } }
        __syncthreads();
#pragma unroll
        for (int tt = 0; tt < 4; ++tt)
#pragma unroll
            for (int i = 0; i < 4; ++i) part[(w * 64 + 16 * tt + 4 * q + i) * 16 + r16] = acc[tt][i];
        if (tid < 64) rsl[tid] = 1.f / sqrtf(rsum * (1.f / D) + EPS);
        __syncthreads();
#pragma unroll
        for (int e = 0; e < 2; ++e) { const int idx = tid + 512 * e; float sm = 0.f;
#pragma unroll
            for (int ww = 0; ww < 8; ++ww) sm += part[ww * 1024 + idx];
            gl[idx] = sm * rsl[idx >> 4]; }
        __syncthreads();
    }
    const int kc = half * 512 + tid, h = kc >> 8, kk = kc & 255;
    float wv[16];
#pragma unroll
    for (int j = 0; j < 16; ++j) wv[j] = wgu[j * KW + kc];
    const float bias = bgate[kc];
    const bf16_t* kp = proj + tok0 * GPROJ + KW + kc;
    float la[CH]; float total = 0.f;
#pragma unroll
    for (int t = 0; t < CH; ++t) {
        float z = bias;
#pragma unroll
        for (int j4 = 0; j4 < 4; ++j4) { const f32x4 gq = *(const LAS f32x4*)(gl + t * 16 + 4 * j4); z += gq.x * wv[4 * j4] + gq.y * wv[4 * j4 + 1] + gq.z * wv[4 * j4 + 2] + gq.w * wv[4 * j4 + 3]; }
        la[t] = logsig16(z); total += la[t];
    }
    dch[(size_t)bc * KW + kc] = __expf(total);
    bf16_t* outp = kdt + (((size_t)bc * NH + h) * DK + kk) * CH;
    float cum = 0.f;
#pragma unroll
    for (int t8 = 0; t8 < CH; t8 += 8) {
        float r[8];
#pragma unroll
        for (int tt = 0; tt < 8; ++tt) { const int t = t8 + tt; cum += la[t]; r[tt] = bf2f(kp[(size_t)t * GPROJ]) * __expf(total - cum); }
        u32x4 o; o.x = pk2(r[0], r[1]); o.y = pk2(r[2], r[3]); o.z = pk2(r[4], r[5]); o.w = pk2(r[6], r[7]);
        *(u32x4*)(outp + t8) = o;
    }
}

constexpr int GS_KD = 0, GS_KD_STRIDE = 144, GS_Q = 36864, GS_Q_STRIDE = 528, GS_V = GS_Q + 64 * 528, GS_V_STRIDE = 80, GS_D = GS_V + 64 * 80, GS_PART = 77824;
static_assert(GS_D + 1024 <= GS_PART && GS_PART + 32768 <= 131072, "gla scan lds");
__device__ __forceinline__ void gla_scan_unit(LAS unsigned char* lds, const int tid, int unit, const bf16_t* __restrict__ proj, const bf16_t* __restrict__ kdt, const float* __restrict__ dch, bf16_t* __restrict__ o) {
    const int w = __builtin_amdgcn_readfirstlane(tid >> 6), lane = tid & 63, r16 = lane & 15, q = lane >> 4, kq = w & 3, vh = w >> 2;
    const int b = unit >> 6, h = (unit >> 4) & 3, vs = unit & 15;
    f32x4 acc[4];
#pragma unroll
    for (int m = 0; m < 4; ++m) acc[m] = (f32x4){0.f, 0.f, 0.f, 0.f};
    u32x4 pk[4], pq[4], pv; float pd = 0.f;
    auto issue = [&](int c) {
        const bf16_t* ksrc = kdt + ((size_t)(b * NCH + c) * NH + h) * DK * CH;
        const size_t tok0 = (size_t)b * SEQ + (size_t)c * CH;
#pragma unroll
        for (int i = 0; i < 4; ++i) { const int p = tid + 512 * i; pk[i] = *(const u32x4*)(ksrc + (size_t)p * 8); }
#pragma unroll
        for (int i = 0; i < 4; ++i) { const int p = tid + 512 * i, row = p >> 5, pc = p & 31; pq[i] = *(const u32x4*)(proj + (tok0 + row) * GPROJ + h * DK + pc * 8); }
        if (tid < 256) { const int row = tid >> 2, pc = tid & 3; pv = *(const u32x4*)(proj + (tok0 + row) * GPROJ + 2 * KW + h * DV + vs * 32 + pc * 8);
            pd = dch[(size_t)(b * NCH + c) * KW + h * DK + tid]; }
    };
    issue(0);
    for (int c = 0; c < NCH; ++c) {
        __syncthreads();
#pragma unroll
        for (int i = 0; i < 4; ++i) { const int p = tid + 512 * i, row = p >> 3, pc = p & 7; *(LAS u32x4*)(lds + GS_KD + row * GS_KD_STRIDE + pc * 16) = pk[i]; }
#pragma unroll
        for (int i = 0; i < 4; ++i) { const int p = tid + 512 * i, row = p >> 5, pc = p & 31; *(LAS u32x4*)(lds + GS_Q + row * GS_Q_STRIDE + pc * 16) = pq[i]; }
        if (tid < 256) { const int row = tid >> 2, pc = tid & 3; *(LAS u32x4*)(lds + GS_V + row * GS_V_STRIDE + pc * 16) = pv; *(LAS float*)(lds + GS_D + tid * 4) = pd; }
        __syncthreads();
        if (c + 1 < NCH) issue(c + 1);
#pragma unroll
        for (int m = 0; m < 4; ++m) { const f32x4 dv = *(const LAS f32x4*)(lds + GS_D + (64 * kq + 16 * m + 4 * q) * 4); acc[m] = acc[m] * dv; }
#pragma unroll
        for (int ks = 0; ks < 2; ++ks) {
            bf16x8 bV;
#pragma unroll
            for (int j = 0; j < 8; ++j) bV[j] = (short)*(const LAS unsigned short*)(lds + GS_V + (32 * ks + 8 * q + j) * GS_V_STRIDE + (16 * vh + r16) * 2);
#pragma unroll
            for (int m = 0; m < 4; ++m) { const bf16x8 a = *(const LAS bf16x8*)(lds + GS_KD + (64 * kq + 16 * m + r16) * GS_KD_STRIDE + (32 * ks + 8 * q) * 2);
                acc[m] = __builtin_amdgcn_mfma_f32_16x16x32_bf16(a, bV, acc[m], 0, 0, 0); }
        }
        f32x4 oacc[4];
#pragma unroll
        for (int tt = 0; tt < 4; ++tt) oacc[tt] = (f32x4){0.f, 0.f, 0.f, 0.f};
#pragma unroll
        for (int mp = 0; mp < 2; ++mp) {
            union { u32x4 u; bf16x8 v; } bs;
            bs.u.x = pk2(acc[2 * mp][0], acc[2 * mp][1]); bs.u.y = pk2(acc[2 * mp][2], acc[2 * mp][3]);
            bs.u.z = pk2(acc[2 * mp + 1][0], acc[2 * mp + 1][1]); bs.u.w = pk2(acc[2 * mp + 1][2], acc[2 * mp + 1][3]);
#pragma unroll
            for (int tt = 0; tt < 4; ++tt) {
                union { u32x4 u; bf16x8 v; } a;
                const LAS unsigned char* qp = lds + GS_Q + (16 * tt + r16) * GS_Q_STRIDE + (64 * kq + 32 * mp + 4 * q) * 2;
                const u32x2 lo = *(const LAS u32x2*)(qp), hi = *(const LAS u32x2*)(qp + 32);
                a.u.x = lo.x; a.u.y = lo.y; a.u.z = hi.x; a.u.w = hi.y;
                oacc[tt] = __builtin_amdgcn_mfma_f32_16x16x32_bf16(a.v, bs.v, oacc[tt], 0, 0, 0);
            }
        }
#pragma unroll
        for (int tt = 0; tt < 4; ++tt) *(LAS f32x4*)(lds + GS_PART + ((((vh * 4 + kq) * 4 + tt) * 64 + lane) * 16)) = oacc[tt];
        __syncthreads();
        {
            f32x4 sm = *(const LAS f32x4*)(lds + GS_PART + ((((vh * 4 + 0) * 4 + kq) * 64 + lane) * 16));
#pragma unroll
            for (int k2 = 1; k2 < 4; ++k2) sm = sm + *(const LAS f32x4*)(lds + GS_PART + ((((vh * 4 + k2) * 4 + kq) * 64 + lane) * 16));
            const size_t tok0 = (size_t)b * SEQ + (size_t)c * CH;
#pragma unroll
            for (int i = 0; i < 4; ++i) {
                const unsigned wv = pk2(sm[i] * 0.0625f, 0.f);
                o[(tok0 + 16 * kq + 4 * q + i) * VW + h * DV + vs * 32 + 16 * vh + r16] = (bf16_t)(wv & 0xffffu);
            }
        }
    }
}

__device__ __forceinline__ void gla_onorm_rows(const bf16_t* __restrict__ o, const bf16_t* __restrict__ proj, const float* __restrict__ onorm, bf16_t* __restrict__ y, int gw, int NGW, int lane) {
    const f32x4 g0 = *(const f32x4*)(onorm + 8 * lane), g1 = *(const f32x4*)(onorm + 8 * lane + 4);
    const float gg[8] = {g0.x, g0.y, g0.z, g0.w, g1.x, g1.y, g1.z, g1.w};
    for (int m0 = gw; m0 < M; m0 += 2 * NGW) {
        u32x4 ov[2][4], rv[2][4];
#pragma unroll
        for (int e = 0; e < 2; ++e) { const int m = m0 + e * NGW; if (m < M) {
            const u32x4* op = (const u32x4*)(o + (size_t)m * VW) + lane; const u32x4* rp = (const u32x4*)(proj + (size_t)m * GPROJ + 2 * KW + VW) + lane;
#pragma unroll
            for (int hh = 0; hh < 4; ++hh) { ov[e][hh] = op[64 * hh]; rv[e][hh] = rp[64 * hh]; } } }
#pragma unroll
        for (int e = 0; e < 2; ++e) { const int m = m0 + e * NGW; if (m < M) {
            u32x4* yp = (u32x4*)(y + (size_t)m * VW) + lane;
#pragma unroll
            for (int hh = 0; hh < 4; ++hh) {
                const u32x4 ovv = ov[e][hh], rvv = rv[e][hh];
                const float x[8] = {bflo(ovv.x), bfhi(ovv.x), bflo(ovv.y), bfhi(ovv.y), bflo(ovv.z), bfhi(ovv.z), bflo(ovv.w), bfhi(ovv.w)};
                const float r[8] = {bflo(rvv.x), bfhi(rvv.x), bflo(rvv.y), bfhi(rvv.y), bflo(rvv.z), bfhi(rvv.z), bflo(rvv.w), bfhi(rvv.w)};
                float sq = 0.f;
#pragma unroll
                for (int j = 0; j < 8; ++j) sq += x[j] * x[j];
                const float rstd = 1.f / sqrtf(wave_sum(sq) * (1.f / DV) + EPS);
                float z[8];
#pragma unroll
                for (int j = 0; j < 8; ++j) z[j] = x[j] * rstd * gg[j] * (r[j] / (1.f + __expf(-r[j])));
                u32x4 wv; wv.x = pk2(z[0], z[1]); wv.y = pk2(z[2], z[3]); wv.z = pk2(z[4], z[5]); wv.w = pk2(z[6], z[7]);
                yp[64 * hh] = wv;
            } } }
    }
}

constexpr int S5_BBT = 0, S5_AR = 4096, S5_AI = 4352, S5_PR = 4608, S5_PI = 4864, S5_ESEG = 5120, S5_WAVE = 9216, S5_WAVE_BYTES = 12288;
static_assert(S5_WAVE + 8 * S5_WAVE_BYTES <= 131072, "s5 lds");
__device__ __forceinline__ float gelu_tanh(float x) { const float z = 0.7978845608028654f * (x + 0.044715f * x * x * x); const float e = __expf(2.f * z); return 0.5f * x * (2.f - 2.f / (e + 1.f)); }
__device__ __forceinline__ void s5_scan_unit(LAS unsigned char* lds, const int tid, int unit, const float* __restrict__ ug, const float* __restrict__ lam_re, const float* __restrict__ lam_im, const float* __restrict__ log_dt,
                                             const float* __restrict__ b_re, const float* __restrict__ b_im, const float* __restrict__ c_re, const float* __restrict__ c_im, const float* __restrict__ dsk, bf16_t* __restrict__ ys) {
    const int w = __builtin_amdgcn_readfirstlane(tid >> 6), lane = tid & 63, r16 = lane & 15, q = lane >> 4;
    const int b = unit >> 6, g = unit & 63;
    __syncthreads();
    if (tid < 64) {
        const int n = tid;
        const float lr = fminf(lam_re[g * S5N + n], -1e-4f), li = lam_im[g * S5N + n], dt = expf(log_dt[g]);
        const float mag = expf(lr * dt), ang = li * dt;
        const float kf = rintf(ang * 0.15915494309189535f); const float rr = fmaf(-kf, 6.2831854820251465f, ang); const float red = fmaf(-kf, -1.7484555e-7f, rr);
        const float cs = cosf(red), sn = sinf(red);
        const float are = mag * cs, aim = mag * sn;
        const float den = lr * lr + li * li, nr = are - 1.f;
        const float fre = (nr * lr + aim * li) / den, fim = (aim * lr - nr * li) / den;
        *(LAS float*)(lds + S5_AR + 4 * n) = are; *(LAS float*)(lds + S5_AI + 4 * n) = aim;
        float pr = are, pi = aim;
#pragma unroll
        for (int s = 0; s < 8; ++s) { const float t0 = pr * pr - pi * pi, t1 = 2.f * pr * pi; pr = t0; pi = t1; }
        *(LAS float*)(lds + S5_PR + 4 * n) = pr; *(LAS float*)(lds + S5_PI + 4 * n) = pi;
        const float* brp = b_re + ((size_t)g * S5N + n) * 16; const float* bip = b_im + ((size_t)g * S5N + n) * 16;
        LAS bf16_t* bbt = (LAS bf16_t*)(lds + S5_BBT);
#pragma unroll
        for (int c = 0; c < 16; c += 2) {
            const float br0 = brp[c], bi0 = bip[c], br1 = brp[c + 1], bi1 = bip[c + 1];
            *(LAS unsigned*)(bbt + n * 16 + c) = pk2(fre * br0 - fim * bi0, fre * br1 - fim * bi1);
            *(LAS unsigned*)(bbt + (64 + n) * 16 + c) = pk2(fre * bi0 + fim * br0, fre * bi1 + fim * br1);
        }
    }
    __syncthreads();
    bf16x8 bB[8];
#pragma unroll
    for (int j = 0; j < 8; ++j) { if (q < 2) bB[j] = *(const LAS bf16x8*)(lds + S5_BBT + (16 * j + r16) * 32 + q * 16); else bB[j] = (bf16x8){0, 0, 0, 0, 0, 0, 0, 0}; }
    bf16x8 bC[4];
#pragma unroll
    for (int ks = 0; ks < 4; ++ks) {
        const int n0 = 16 * ks + 4 * q;
        const f32x4 cr = *(const f32x4*)(c_re + ((size_t)g * 16 + r16) * S5N + n0), ci = *(const f32x4*)(c_im + ((size_t)g * 16 + r16) * S5N + n0);
        union { u32x4 u; bf16x8 v; } t; t.u.x = pk2(cr.x, -ci.x); t.u.y = pk2(cr.y, -ci.y); t.u.z = pk2(cr.z, -ci.z); t.u.w = pk2(cr.w, -ci.w);
        bC[ks] = t.v;
    }
    const float dk = dsk[g * 16 + r16];
    const float are = *(const LAS float*)(lds + S5_AR + 4 * lane), aim = *(const LAS float*)(lds + S5_AI + 4 * lane);
    LAS float* bu = (LAS float*)(lds + S5_WAVE + w * S5_WAVE_BYTES);
    LAS unsigned* xs = (LAS unsigned*)(lds + S5_WAVE + w * S5_WAVE_BYTES + 8192);
    const float* useg = ug + ((size_t)(b * S5G + g) * SEQ + 256 * w) * 16;
    float xr = 0.f, xi = 0.f;
#pragma unroll 1
    for (int pass = 0; pass < 2; ++pass) {
        if (pass == 1) {
            *(LAS float*)(lds + S5_ESEG + (w * 64 + lane) * 8) = xr; *(LAS float*)(lds + S5_ESEG + (w * 64 + lane) * 8 + 4) = xi;
            __syncthreads();
            const float pr = *(const LAS float*)(lds + S5_PR + 4 * lane), pi = *(const LAS float*)(lds + S5_PI + 4 * lane);
            float cr = 0.f, ci = 0.f;
            for (int ww = 0; ww < w; ++ww) { const float er = *(const LAS float*)(lds + S5_ESEG + (ww * 64 + lane) * 8), ei = *(const LAS float*)(lds + S5_ESEG + (ww * 64 + lane) * 8 + 4);
                const float t0 = pr * cr - pi * ci + er, t1 = pr * ci + pi * cr + ei; cr = t0; ci = t1; }
            xr = cr; xi = ci;
        }
        f32x4 nu0 = (f32x4){0.f, 0.f, 0.f, 0.f}, nu1 = nu0; float nuv[4] = {0.f, 0.f, 0.f, 0.f};
        if (q < 2) { nu0 = *(const f32x4*)(useg + r16 * 16 + 8 * q); nu1 = *(const f32x4*)(useg + r16 * 16 + 8 * q + 4); }
        if (pass == 1) {
#pragma unroll
            for (int i = 0; i < 4; ++i) nuv[i] = useg[(4 * q + i) * 16 + r16];
        }
#pragma unroll 1
        for (int sc = 0; sc < 16; ++sc) {
            union { u32x4 u; bf16x8 v; } a;
            a.u.x = pk2(nu0.x, nu0.y); a.u.y = pk2(nu0.z, nu0.w); a.u.z = pk2(nu1.x, nu1.y); a.u.w = pk2(nu1.z, nu1.w);
            float uv[4];
#pragma unroll
            for (int i = 0; i < 4; ++i) uv[i] = nuv[i];
            if (sc + 1 < 16) {
                const float* up = useg + (size_t)(16 * (sc + 1)) * 16;
                if (q < 2) { nu0 = *(const f32x4*)(up + r16 * 16 + 8 * q); nu1 = *(const f32x4*)(up + r16 * 16 + 8 * q + 4); }
                if (pass == 1) {
#pragma unroll
                    for (int i = 0; i < 4; ++i) nuv[i] = up[(4 * q + i) * 16 + r16];
                }
            }
#pragma unroll
            for (int j = 0; j < 4; ++j) {
                const f32x4 rr = __builtin_amdgcn_mfma_f32_16x16x32_bf16(a.v, bB[j], (f32x4){0.f, 0.f, 0.f, 0.f}, 0, 0, 0);
                const f32x4 ri = __builtin_amdgcn_mfma_f32_16x16x32_bf16(a.v, bB[j + 4], (f32x4){0.f, 0.f, 0.f, 0.f}, 0, 0, 0);
#pragma unroll
                for (int i = 0; i < 4; ++i) *(LAS f32x2*)(bu + ((4 * q + i) * 64 + 16 * j + r16) * 2) = (f32x2){rr[i], ri[i]};
            }
            LDS_WAIT(); asm volatile("" ::: "memory");
            if (pass == 0) {
#pragma unroll
                for (int t = 0; t < 16; ++t) { const f32x2 bb = *(const LAS f32x2*)(bu + (t * 64 + lane) * 2); const float br = bb.x, bi = bb.y;
                    const float t0 = are * xr - aim * xi + br, t1 = are * xi + aim * xr + bi; xr = t0; xi = t1; }
            } else {
#pragma unroll
                for (int t = 0; t < 16; ++t) { const f32x2 bb = *(const LAS f32x2*)(bu + (t * 64 + lane) * 2); const float br = bb.x, bi = bb.y;
                    const float t0 = are * xr - aim * xi + br, t1 = are * xi + aim * xr + bi; xr = t0; xi = t1;
                    xs[t * 64 + lane] = pk2(xr, xi); }
                LDS_WAIT(); asm volatile("" ::: "memory");
                f32x4 ya = (f32x4){0.f, 0.f, 0.f, 0.f};
#pragma unroll
                for (int ks = 0; ks < 4; ++ks) { const bf16x8 xa = *(const LAS bf16x8*)((const LAS unsigned char*)xs + r16 * 256 + (32 * ks + 8 * q) * 2);
                    ya = __builtin_amdgcn_mfma_f32_16x16x32_bf16(xa, bC[ks], ya, 0, 0, 0); }
                const size_t tok0 = (size_t)b * SEQ + 256 * w + 16 * sc;
#pragma unroll
                for (int i = 0; i < 4; ++i) { const float yv = gelu_tanh(ya[i] + dk * uv[i]);
                    ys[(tok0 + 4 * q + i) * S5W + g * 16 + r16] = (bf16_t)(pk2(yv, 0.f) & 0xffffu); }
            }
            LDS_WAIT(); asm volatile("" ::: "memory");
        }
    }
}

#define XB_TMO      128
#define XB_XCNT(j)  (256  + 64 * (j))
#define XB_XSUB(j)  (1280 + 64 * (j))
#define XB_XGEN(j)  (2304 + 64 * (j))
#define XB_TOP      3328
#define XB_TOPGEN   3392
#define XCD_BAR_WORDS 3456
#define XB_SPIN_CAP (1u << 20)
__device__ __forceinline__ unsigned xb_ld(unsigned* p)              { return __hip_atomic_load(p, __ATOMIC_RELAXED, __HIP_MEMORY_SCOPE_AGENT); }
__device__ __forceinline__ unsigned xb_add(unsigned* p, unsigned v) { return __hip_atomic_fetch_add(p, v, __ATOMIC_RELAXED, __HIP_MEMORY_SCOPE_AGENT); }
__device__ __forceinline__ unsigned xb_xcc_id() { return (unsigned)__builtin_amdgcn_s_getreg((3 << 11) | 20) & 0xFu; }
#define XB_SPIN(cond, bar) do { unsigned _sp = 0; while (cond) { __builtin_amdgcn_s_sleep(1); \
    if ((++_sp & 255u) == 0u) { if (xb_ld(&(bar)[XB_TMO])) break; if (_sp > XB_SPIN_CAP) { atomicAdd(&(bar)[XB_TMO], 1u); break; } } } } while (0)
__device__ __forceinline__ void xcd_barrier_post(unsigned* bar) { if (threadIdx.x == 0) (void)xb_add(&bar[XB_XCNT(xb_xcc_id())], 1u); }
__device__ __forceinline__ void xcd_barrier_complete(unsigned* bar, unsigned x, unsigned& nloc, unsigned& nx) {
    const unsigned G = gridDim.x;
    unsigned sum, cnt, mine, sp = 0u;
    for (;;) {
        sum = 0u; cnt = 0u; mine = 0u;
#pragma unroll
        for (unsigned j = 0; j < 16; ++j) { const unsigned c = xb_ld(&bar[XB_XCNT(j)]); sum += c; cnt += (c > 0u) ? 1u : 0u; mine = (j == x) ? c : mine; }
        if (sum == G) break;
        __builtin_amdgcn_s_sleep(1);
        if ((++sp & 255u) == 0u) { if (xb_ld(&bar[XB_TMO])) break; if (sp > XB_SPIN_CAP) { atomicAdd(&bar[XB_TMO], 1u); break; } }
    }
    nloc = mine > 0u ? mine : 1u; nx = cnt > 0u ? cnt : 1u;
}
__device__ __forceinline__ void xcd_barrier(unsigned* bar, volatile LAS unsigned* st) {
    asm volatile("s_waitcnt vmcnt(0)" ::: "memory");
    __syncthreads();
    if (threadIdx.x == 0) {
        const unsigned x = xb_xcc_id();
        __builtin_amdgcn_s_waitcnt(0);
        unsigned nloc = st[0], nx = st[1];
        if (nloc == 0u) { xcd_barrier_complete(bar, x, nloc, nx); st[0] = nloc; st[1] = nx; }
        const unsigned old = xb_add(&bar[XB_XSUB(x)], 1u);
        const unsigned gen = old / nloc;
        if (old + 1u == (gen + 1u) * nloc) {
            __builtin_amdgcn_fence(__ATOMIC_RELEASE, "agent");
            asm volatile("s_waitcnt vmcnt(0)" ::: "memory");
            const unsigned og = xb_add(&bar[XB_TOP], 1u);
            const unsigned tg = og / nx;
            if (og + 1u == (tg + 1u) * nx) xb_add(&bar[XB_TOPGEN], 1u);
            else XB_SPIN(xb_ld(&bar[XB_TOPGEN]) == tg, bar);
            __builtin_amdgcn_fence(__ATOMIC_ACQUIRE, "agent");
            xb_add(&bar[XB_XGEN(x)], 1u);
            asm volatile("s_waitcnt vmcnt(0)" ::: "memory");
        } else {
            XB_SPIN(xb_ld(&bar[XB_XGEN(x)]) == gen, bar);
            __builtin_amdgcn_fence(__ATOMIC_ACQUIRE, "agent");
            asm volatile("s_waitcnt vmcnt(0)" ::: "memory");
        }
    }
    __syncthreads();
}

struct Args { const float* in[22]; float* out; unsigned char* ws; int ph_lo, ph_hi; };
constexpr int PH_PER_LAYER = 9, PH_FINAL = 1 + DEPTH * PH_PER_LAYER, PH_END = PH_FINAL + 1;

typedef const Args __attribute__((address_space(4)))* ArgsP;
__device__ __forceinline__ ArgsP launder_args() { ArgsP p = (ArgsP)__builtin_amdgcn_kernarg_segment_ptr(); asm volatile("" : "+s"(p)); return p; }
__global__ void __launch_bounds__(NTHREADS, 2) fwd_kernel(Args args_unused) {
    extern __shared__ __attribute__((aligned(16))) unsigned char lds_raw[];
    LAS unsigned char* lds = (LAS unsigned char*)lds_raw;
    int lo, hi; { ArgsP a = launder_args(); lo = a->ph_lo; hi = a->ph_hi; }
    if (threadIdx.x < 16) ((LAS unsigned*)(lds + LDS_MISC))[threadIdx.x] = 0u;
    __syncthreads();
    if (hi - lo > 1) {
        { ArgsP a = launder_args(); xcd_barrier_post((unsigned*)(a->ws + WS_CTL)); }
        cg::this_grid().sync();
    }
#define PH_LOCALS int tid = threadIdx.x; asm volatile("" : "+v"(tid)); int bx = blockIdx.x; asm volatile("" : "+s"(bx)); int G = gridDim.x; asm volatile("" : "+s"(G)); \
    const int lane = tid & 63, wave = __builtin_amdgcn_readfirstlane(tid >> 6), gw = bx * NWAVES + wave, NGW = G * NWAVES; (void)lane; (void)wave; (void)gw; (void)NGW; ArgsP a = launder_args();

#define PH_RUN(id) (lo <= (id) && (id) < hi)
#define PH_SEAM(id) do { if ((id) + 1 < hi) { ArgsP a_ = launder_args(); xcd_barrier((unsigned*)(a_->ws + WS_CTL), (volatile LAS unsigned*)(lds + LDS_MISC)); } } while (0)
#define WSP(T, off) ((T*)(a->ws + (off)))

    if (PH_RUN(0)) {
        PH_LOCALS unsigned char* ws = a->ws;
        LAS float* scr = (LAS float*)(lds + wave * 16640);
        constexpr int GIN_NB = (GIN + 63) / 64; constexpr int I_GIN = (D / 64) * GIN_NB, I_GOUT = (VW / 64) * (D / 64), I_SIN = (D / 64) * (S5W / 64), I_SOUT = (S5W / 64) * (2 * D / 64), I_UP = (D / 64) * (FF / 64), I_DN = (FF / 64) * (D / 64);
        constexpr int NITEMS = 2 * I_GIN + 2 * I_GOUT + 2 * I_SIN + 2 * I_SOUT + 4 * I_UP + 4 * I_DN;
        for (int rep = 0; rep < ((PROBE_MASK & 2) ? 2 : 1); ++rep)
        for (int it = gw; it < NITEMS; it += NGW) {
            int r = it;
            if (r < 2 * I_GIN) { const int j = r / I_GIN; r %= I_GIN; const int nnb = GIN_NB;
                tr_item(a->in[2] + (size_t)j * D * GIN, D, GIN, (bf16_t*)(ws + WS_WGIN) + (size_t)j * GIN_PAD * D, scr, r / nnb, r % nnb, lane, false, a->in[1] + (size_t)j * D); continue; } r -= 2 * I_GIN;
            if (r < 2 * I_GOUT) { const int j = r / I_GOUT; r %= I_GOUT; const int nnb = D / 64;
                tr_item(a->in[6] + (size_t)j * VW * D, VW, D, (bf16_t*)(ws + WS_WGOUT) + (size_t)j * D * VW, scr, r / nnb, r % nnb, lane, false, nullptr); continue; } r -= 2 * I_GOUT;
            if (r < 2 * I_SIN) { const int j = r / I_SIN; r %= I_SIN; const int nnb = S5W / 64;
                tr_item(a->in[8] + (size_t)j * D * S5W, D, S5W, (bf16_t*)(ws + WS_WSIN) + (size_t)j * S5W * D, scr, r / nnb, r % nnb, lane, false, a->in[7] + (size_t)j * D); continue; } r -= 2 * I_SIN;
            if (r < 2 * I_SOUT) { const int j = r / I_SOUT; r %= I_SOUT; const int nnb = 2 * D / 64;
                tr_item(a->in[17] + (size_t)j * S5W * 2 * D, S5W, 2 * D, (bf16_t*)(ws + WS_WSOUT) + (size_t)j * 2 * D * S5W, scr, r / nnb, r % nnb, lane, true, nullptr); continue; } r -= 2 * I_SOUT;
            if (r < 4 * I_UP) { const int j = r / I_UP; r %= I_UP; const int nnb = FF / 64;
                tr_item(a->in[19] + (size_t)j * D * FF, D, FF, (bf16_t*)(ws + WS_WUP) + (size_t)j * FF * D, scr, r / nnb, r % nnb, lane, false, a->in[18] + (size_t)j * D); continue; } r -= 4 * I_UP;
            { const int j = r / I_DN; r %= I_DN; const int nnb = D / 64;
                tr_item(a->in[20] + (size_t)j * FF * D, FF, D, (bf16_t*)(ws + WS_WDN) + (size_t)j * D * FF, scr, r / nnb, r % nnb, lane, false, nullptr); }
        }
        prep_rows(a->in[0], WSP(bf16_t, WS_HN), WSP(float, WS_SS), gw, NGW, lane);
        PH_SEAM(0);
    }

#pragma unroll 1
    for (int layer = 0; layer < DEPTH; ++layer) {
        const int pb = 1 + layer * PH_PER_LAYER, j = layer >> 1;
        if ((layer & 1) == 0) {
            if (PH_RUN(pb + 1)) {
                PH_LOCALS
                pg8::Gemm gm{WSP(const bf16_t, WS_HN), WSP(const bf16_t, WS_WGIN) + (size_t)j * GIN_PAD * D};
                pg8::rstd_prestep<GPROJ>(lds, tid, G, bx, WSP(const float, WS_SS), 32);
                pg8::EpiProj E{WSP(bf16_t, WS_PROJ), (const LAS float*)(lds + LDS_RSTD)};
                pg8::gemm_phase<pg8::EpiProj, GPROJ, D>(lds, tid, gm, G, bx, E);
                PH_SEAM(pb + 1);
            }
            if (PH_RUN(pb + 2)) {
                PH_LOCALS
                for (int rep = 0; rep < ((PROBE_MASK & 8) ? 2 : 1); ++rep)
                for (int u = bx; u < BATCH * NCH * 2; u += G) gla_gate_unit(lds, tid, u, WSP(const bf16_t, WS_HN), WSP(const float, WS_SS), WSP(const bf16_t, WS_WGIN) + (size_t)j * GIN_PAD * D + (size_t)GPROJ * D, WSP(const bf16_t, WS_PROJ), a->in[3] + (size_t)j * 16 * KW, a->in[4] + (size_t)j * KW, WSP(bf16_t, WS_KDT), WSP(float, WS_DCH));
                PH_SEAM(pb + 2);
            }
            if (PH_RUN(pb + 3)) {
                PH_LOCALS
                for (int rep = 0; rep < ((PROBE_MASK & 16) ? 2 : 1); ++rep)
                for (int u0 = bx; u0 < BATCH * NH * 16; u0 += G) { const int u = (G == 256) ? (u0 & 7) * 32 + (u0 >> 3) : u0; gla_scan_unit(lds, tid, u, WSP(const bf16_t, WS_PROJ), WSP(const bf16_t, WS_KDT), WSP(const float, WS_DCH), WSP(bf16_t, WS_O)); __syncthreads(); }
                PH_SEAM(pb + 3);
            }
            if (PH_RUN(pb + 4)) { PH_LOCALS for (int rep = 0; rep < ((PROBE_MASK & 8) ? 2 : 1); ++rep) gla_onorm_rows(WSP(const bf16_t, WS_O), WSP(const bf16_t, WS_PROJ), a->in[5] + (size_t)j * DV, WSP(bf16_t, WS_Y), gw, NGW, lane); PH_SEAM(pb + 4); }
            if (PH_RUN(pb + 5)) {
                PH_LOCALS
                pg8::Gemm gm{WSP(const bf16_t, WS_Y), WSP(const bf16_t, WS_WGOUT) + (size_t)j * D * VW};
                pg8::EpiResid E{layer == 0 ? a->in[0] : a->out, a->out, WSP(bf16_t, WS_HN), WSP(float, WS_SS)};
                pg8::gemm_phase<pg8::EpiResid, D, VW>(lds, tid, gm, G, bx, E);
                PH_SEAM(pb + 5);
            }
        } else {
            if (PH_RUN(pb + 1)) {
                PH_LOCALS
                pg8::Gemm gm{WSP(const bf16_t, WS_HN), WSP(const bf16_t, WS_WSIN) + (size_t)j * S5W * D};
                pg8::rstd_prestep<S5W>(lds, tid, G, bx, WSP(const float, WS_SS), 32);
                pg8::EpiU E{WSP(float, WS_UG), (const LAS float*)(lds + LDS_RSTD)};
                pg8::gemm_phase<pg8::EpiU, S5W, D>(lds, tid, gm, G, bx, E);
                PH_SEAM(pb + 1);
            }
            if (PH_RUN(pb + 2)) {
                PH_LOCALS
                for (int rep = 0; rep < ((PROBE_MASK & 32) ? 2 : 1); ++rep)
                for (int u0 = bx; u0 < BATCH * S5G; u0 += G) { const int u = (G == 256) ? (u0 & 7) * 32 + (u0 >> 3) : u0;
                    s5_scan_unit(lds, tid, u, WSP(const float, WS_UG), a->in[9] + (size_t)j * S5G * S5N, a->in[10] + (size_t)j * S5G * S5N, a->in[11] + (size_t)j * S5G, a->in[12] + (size_t)j * S5G * S5N * 16, a->in[13] + (size_t)j * S5G * S5N * 16,
                                 a->in[14] + (size_t)j * S5G * 16 * S5N, a->in[15] + (size_t)j * S5G * 16 * S5N, a->in[16] + (size_t)j * S5W, WSP(bf16_t, WS_YS)); }
                PH_SEAM(pb + 2);
            }
            if (PH_RUN(pb + 3)) {
                PH_LOCALS
                pg8::Gemm gm{WSP(const bf16_t, WS_YS), WSP(const bf16_t, WS_WSOUT) + (size_t)j * 2 * D * S5W};
                pg8::EpiGlu E{a->out, a->out, WSP(bf16_t, WS_HN), WSP(float, WS_SS)};
                pg8::gemm_phase<pg8::EpiGlu, 2 * D, S5W>(lds, tid, gm, G, bx, E);
                PH_SEAM(pb + 3);
            }
        }
        if (PH_RUN(pb + 7)) {
            PH_LOCALS
            pg8::Gemm gm{WSP(const bf16_t, WS_HN), WSP(const bf16_t, WS_WUP) + (size_t)layer * FF * D};
            pg8::rstd_prestep<FF>(lds, tid, G, bx, WSP(const float, WS_SS), (layer & 1) ? 64 : 32);
            pg8::EpiRelu2 E{WSP(bf16_t, WS_A), (const LAS float*)(lds + LDS_RSTD)};
            if (PROBE_MASK & 128) pg8::gemm_phase<pg8::EpiRelu2, FF, D>(lds, tid, gm, G, bx, E);
            pg8::gemm_phase<pg8::EpiRelu2, FF, D>(lds, tid, gm, G, bx, E);
            PH_SEAM(pb + 7);
        }
        if (PH_RUN(pb + 8)) {
            PH_LOCALS
            pg8::Gemm gm{WSP(const bf16_t, WS_A), WSP(const bf16_t, WS_WDN) + (size_t)layer * D * FF};
            pg8::EpiResid E{a->out, a->out, WSP(bf16_t, WS_HN), WSP(float, WS_SS)};
            pg8::gemm_phase<pg8::EpiResid, D, FF, true>(lds, tid, gm, G, bx, E);
            PH_SEAM(pb + 8);
        }
    }
    if (PROBE_MASK & 1) { for (int i = 0; i < 32; ++i) PH_SEAM(0); }
    if (PH_RUN(PH_FINAL)) { PH_LOCALS norm_rows_f32(a->out, a->in[21], gw, NGW, lane); }
#undef PH_RUN
#undef PH_SEAM
#undef WSP
}

extern "C" void kernel_launch(void* const* d_in, const int* in_sizes, int n_in, void* d_out, int out_size, void* d_ws, size_t ws_size, hipStream_t stream) {
    static int grid = 0;
    if (grid == 0) {
        if (n_in != 22 || out_size != M * D || ws_size < WS_END) { fprintf(stderr, "kernel_launch: unexpected shapes (n_in %d out %d ws %zu, need %zu)\n", n_in, out_size, ws_size, (size_t)WS_END); grid = -1; return; }
        int dev = 0, cus = 0, per_cu = 0;
        (void)hipGetDevice(&dev);
        (void)hipDeviceGetAttribute(&cus, hipDeviceAttributeMultiprocessorCount, dev);
        if (hipFuncSetAttribute((const void*)fwd_kernel, hipFuncAttributeMaxDynamicSharedMemorySize, LDS_BYTES) != hipSuccess) { fprintf(stderr, "kernel_launch: hipFuncSetAttribute failed\n"); grid = -1; return; }
        if (hipOccupancyMaxActiveBlocksPerMultiprocessor(&per_cu, (const void*)fwd_kernel, NTHREADS, LDS_BYTES) != hipSuccess || per_cu < 1) { fprintf(stderr, "kernel_launch: occupancy query says %d\n", per_cu); per_cu = 1; }
        (void)hipGetLastError();
        grid = cus * 1;
        if (grid <= 0) grid = 256;
    }
    if (grid < 0) return;
    (void)hipMemsetAsync((unsigned char*)d_ws + WS_CTL, 0, CTL_BYTES, stream);
    Args a{};
    for (int i = 0; i < 22; ++i) a.in[i] = (const float*)d_in[i];
    a.out = (float*)d_out; a.ws = (unsigned char*)d_ws;
#if MK_MULTI
    for (int ph = 0; ph < PH_END; ++ph) {
        if (ph >= 1 && ph < PH_FINAL) { const int l = (ph - 1) / PH_PER_LAYER, s = (ph - 1) % PH_PER_LAYER; if ((l & 1) && (s == 4 || s == 5)) continue; if (s == 6 || s == 0) continue; }
        a.ph_lo = ph; a.ph_hi = ph + 1;
        hipLaunchKernelGGL(fwd_kernel, dim3(grid), dim3(NTHREADS), LDS_BYTES, stream, a);
    }
#else
    a.ph_lo = 0; a.ph_hi = PH_END;
    void* kargs[] = {&a};
    hipError_t e = hipLaunchCooperativeKernel((const void*)fwd_kernel, dim3(grid), dim3(NTHREADS), kargs, LDS_BYTES, stream);
    if (e != hipSuccess) fprintf(stderr, "kernel_launch: cooperative launch failed: %s (grid %d)\n", hipGetErrorString(e), grid);
#endif
}
```
